# Optimizing an MI355X kernel written in HIP

```python
import math
import jax, jax.numpy as jnp
from jax import lax
import numpy as np

D_MODEL = 1024
BATCH = 8
SEQ = 4096
DEPTH = 1

RMS_EPS = 1e-6
ROPE_THETA = 500000.0
ROPE_FRACTION = 4
DA_HEADS = 4
DA_HEAD_DIM = 64
DA_V_DIM = 2 * DA_HEAD_DIM
DA_WIDTH = DA_HEADS * DA_V_DIM
DA_QBLOCK = 128
NSA_HEADS = 8
NSA_GROUPS = 2
NSA_HEAD_DIM = 64
NSA_WIDTH = NSA_HEADS * NSA_HEAD_DIM
CMP_BLOCK = 32
CMP_STRIDE = 16
SEL_BLOCK = 64
SEL_TOPK = 16
WINDOW = 512
NSA_QBLOCK = 64
FORCE_BONUS = 1e4
NEG_LARGE = -1e30
PEER_HEADS = 8
PEER_NKEYS = 128
PEER_TOPK = 16
PEER_DQ = 256
N_EXPERTS = PEER_NKEYS * PEER_NKEYS
PEER_TBLOCK = 128
IN_SPLIT_SIZES = (DA_HEADS * 2 * DA_HEAD_DIM, DA_HEADS * 2 * DA_HEAD_DIM, DA_WIDTH, NSA_WIDTH) + (NSA_GROUPS * NSA_HEAD_DIM,) * 6 + (NSA_HEADS * 3, 2 * D_MODEL)
IN_COLS = sum(IN_SPLIT_SIZES)

kernel_name = 'hybrid_diffattn_nsa_peer_block'


def rmsnorm(x, g):
    xf = x.astype(jnp.float32)
    y = xf * lax.rsqrt(jnp.mean(xf * xf, axis=-1, keepdims=True) + RMS_EPS)
    return (y * g.astype(jnp.float32)).astype(x.dtype)


def partial_rope(x, pos):
    d = x.shape[-1]
    rot = d // ROPE_FRACTION
    half = rot // 2
    inv = jnp.power(ROPE_THETA, -jnp.arange(half, dtype=jnp.float32) * 2.0 / rot)
    ang = pos.astype(jnp.float32)[:, None] * inv[None, :]
    cos = jnp.cos(ang)[None, :, None, :].astype(x.dtype)
    sin = jnp.sin(ang)[None, :, None, :].astype(x.dtype)
    x1 = x[..., :half]
    x2 = x[..., half:rot]
    return jnp.concatenate([x1 * cos - x2 * sin, x2 * cos + x1 * sin, x[..., rot:]], axis=-1)


def diff_attention(q, k, v, lq1, lk1, lq2, lk2, subln, lambda_init):
    B, S, H, _, d = q.shape
    scale = d ** -0.5
    lam = (jnp.exp(jnp.sum(lq1.astype(jnp.float32) * lk1.astype(jnp.float32)))
           - jnp.exp(jnp.sum(lq2.astype(jnp.float32) * lk2.astype(jnp.float32))) + lambda_init)
    kh = k.transpose(0, 2, 3, 1, 4)
    vh = v.transpose(0, 2, 1, 3)
    n_blk = S // DA_QBLOCK
    qb = q.transpose(0, 2, 3, 1, 4).reshape(B, H, 2, n_blk, DA_QBLOCK, d).transpose(3, 0, 1, 2, 4, 5)
    kpos = jnp.arange(S)

    def one_block(args):
        qblk, i = args
        qpos = i * DA_QBLOCK + jnp.arange(DA_QBLOCK)
        s = jnp.einsum('bhcqd,bhckd->bhcqk', qblk, kh).astype(jnp.float32) * scale
        mask = kpos[None, :] <= qpos[:, None]
        p = jax.nn.softmax(jnp.where(mask, s, -jnp.inf), axis=-1)
        attn = p[:, :, 0] - lam * p[:, :, 1]
        return jnp.einsum('bhqk,bhkd->bhqd', attn.astype(vh.dtype), vh)

    o = lax.map(one_block, (qb, jnp.arange(n_blk)))
    o = o.transpose(1, 0, 3, 2, 4).reshape(B, S, H, 2 * d)
    o = rmsnorm(o, subln) * (1.0 - lambda_init)
    return o.reshape(B, S, H * 2 * d)


def compress(kv, pe, w1, w2):
    B, S, G, d = kv.shape
    n_cmp = (S - CMP_BLOCK) // CMP_STRIDE + 1
    idx = jnp.arange(n_cmp)[:, None] * CMP_STRIDE + jnp.arange(CMP_BLOCK)[None, :]
    blocks = kv[:, idx] + pe[None, None, :, None, :]
    flat = blocks.transpose(0, 3, 1, 2, 4).reshape(B, G, n_cmp, CMP_BLOCK * d)
    return jax.nn.gelu(flat @ w1, approximate=False) @ w2


def nsa_attention(q, kc_raw, vc_raw, ks, vs, kw, vw, gates, pe_k, pe_v, w1k, w1v, w2k, w2v):
    B, S, Hq, d = q.shape
    G = NSA_GROUPS
    Hg = Hq // G
    QB = NSA_QBLOCK
    scale = d ** -0.5
    kc = compress(kc_raw, pe_k, w1k, w2k)
    vc = compress(vc_raw, pe_v, w1v, w2v)
    n_cmp = kc.shape[2]
    cmp_end = jnp.arange(n_cmp) * CMP_STRIDE + CMP_BLOCK - 1
    n_sel = S // SEL_BLOCK
    k_sel = min(SEL_TOPK, n_sel)
    ci = jnp.arange(n_cmp)[:, None] * CMP_STRIDE
    sj = jnp.arange(n_sel)[None, :] * SEL_BLOCK
    overlap = ((ci < sj + SEL_BLOCK) & (ci + CMP_BLOCK > sj)).astype(jnp.float32)
    ksh = ks.transpose(0, 2, 1, 3)
    vsh = vs.transpose(0, 2, 1, 3)
    pad = ((0, 0), (0, 0), (WINDOW, 0), (0, 0))
    kwp = jnp.pad(kw.transpose(0, 2, 1, 3), pad)
    vwp = jnp.pad(vw.transpose(0, 2, 1, 3), pad)
    n_blk = S // QB
    qb = q.reshape(B, n_blk, QB, G, Hg, d).transpose(1, 0, 3, 4, 2, 5)
    gb = gates.reshape(B, n_blk, QB, G, Hg, 3).transpose(1, 0, 3, 4, 2, 5)
    b_ix = jnp.arange(B)[:, None, None, None]
    g_ix = jnp.arange(G)[None, :, None, None]
    blk_id = jnp.arange(n_sel)

    def one_block(args):
        qblk, gblk, i = args
        qs = i * QB
        qpos = qs + jnp.arange(QB)
        s = jnp.einsum('bghqd,bgnd->bghqn', qblk, kc).astype(jnp.float32) * scale
        cmask = cmp_end[None, :] <= qpos[:, None]
        p_cmp = jax.nn.softmax(jnp.where(cmask, s, NEG_LARGE), axis=-1) * cmask
        o_cmp = jnp.einsum('bghqn,bgnd->bghqd', p_cmp.astype(vc.dtype), vc)
        imp = jnp.einsum('bghqn,ns->bgqs', p_cmp, overlap)
        cur = qpos // SEL_BLOCK
        valid = blk_id[None, :] <= cur[:, None]
        forced = (blk_id[None, :] == 0) | (blk_id[None, :] == cur[:, None]) | (blk_id[None, :] == cur[:, None] - 1)
        score = jnp.where(valid, imp + jnp.where(forced, FORCE_BONUS, 0.0), -jnp.inf)
        _, sel = lax.top_k(score, k_sel)
        tok = (sel[..., None] * SEL_BLOCK + jnp.arange(SEL_BLOCK)).reshape(B, G, QB, k_sel * SEL_BLOCK)
        kg = ksh[b_ix, g_ix, tok]
        vg = vsh[b_ix, g_ix, tok]
        s = jnp.einsum('bghqd,bgqtd->bghqt', qblk, kg).astype(jnp.float32) * scale
        smask = (tok <= qpos[None, None, :, None])[:, :, None]
        p = jax.nn.softmax(jnp.where(smask, s, -jnp.inf), axis=-1)
        o_sel = jnp.einsum('bghqt,bgqtd->bghqd', p.astype(vg.dtype), vg)
        kwin = lax.dynamic_slice_in_dim(kwp, qs, WINDOW + QB, axis=2)
        vwin = lax.dynamic_slice_in_dim(vwp, qs, WINDOW + QB, axis=2)
        kpos = qs - WINDOW + jnp.arange(WINDOW + QB)
        wmask = (kpos[None, :] <= qpos[:, None]) & (kpos[None, :] > qpos[:, None] - WINDOW) & (kpos[None, :] >= 0)
        s = jnp.einsum('bghqd,bgkd->bghqk', qblk, kwin).astype(jnp.float32) * scale
        p = jax.nn.softmax(jnp.where(wmask, s, -jnp.inf), axis=-1)
        o_win = jnp.einsum('bghqk,bgkd->bghqd', p.astype(vwin.dtype), vwin)
        return gblk[..., 0:1] * o_cmp + gblk[..., 1:2] * o_sel + gblk[..., 2:3] * o_win

    o = lax.map(one_block, (qb, gb, jnp.arange(n_blk)))
    return o.transpose(1, 0, 4, 2, 3, 5).reshape(B, S, Hq * d)


def hybrid_mixer(a, w_in, lq1, lk1, lq2, lk2, subln, lambda_init, pe_k, pe_v, w1k, w1v, w2k, w2v, p_da, p_nsa, w_o):
    B, S, _ = a.shape
    pos = jnp.arange(S)
    z = a @ w_in
    splits = np.cumsum(IN_SPLIT_SIZES)[:-1].tolist()
    q_da, k_da, v_da, q_n, kc, vc, ks, vs, kw, vw, g_n, g_m = jnp.split(z, splits, axis=-1)
    q_da = partial_rope(q_da.reshape(B, S, 2 * DA_HEADS, DA_HEAD_DIM), pos).reshape(B, S, DA_HEADS, 2, DA_HEAD_DIM)
    k_da = partial_rope(k_da.reshape(B, S, 2 * DA_HEADS, DA_HEAD_DIM), pos).reshape(B, S, DA_HEADS, 2, DA_HEAD_DIM)
    v_da = v_da.reshape(B, S, DA_HEADS, DA_V_DIM)
    y_da = diff_attention(q_da, k_da, v_da, lq1, lk1, lq2, lk2, subln, lambda_init)
    kv_shape = (B, S, NSA_GROUPS, NSA_HEAD_DIM)
    q_n = partial_rope(q_n.reshape(B, S, NSA_HEADS, NSA_HEAD_DIM), pos)
    kc = partial_rope(kc.reshape(kv_shape), pos)
    ks = partial_rope(ks.reshape(kv_shape), pos)
    kw = partial_rope(kw.reshape(kv_shape), pos)
    gates = jax.nn.sigmoid(g_n.reshape(B, S, NSA_HEADS, 3))
    y_n = nsa_attention(q_n, kc, vc.reshape(kv_shape), ks, vs.reshape(kv_shape), kw, vw.reshape(kv_shape),
                        gates, pe_k, pe_v, w1k, w1v, w2k, w2v)
    g_a, g_b = jnp.split(jax.nn.sigmoid(g_m), 2, axis=-1)
    merged = g_a * (y_da @ p_da) + g_b * (y_n @ p_nsa)
    return merged @ w_o


def peer(c, w_q, sub_k1, sub_k2, u_tab, v_tab):
    B, S, D = c.shape
    T = B * S
    cf = c.reshape(T, D)
    q = (cf @ w_q).reshape(T, PEER_HEADS, 2, PEER_DQ // 2)
    s1 = jnp.einsum('thd,kd->thk', q[:, :, 0], sub_k1).astype(jnp.float32)
    s2 = jnp.einsum('thd,kd->thk', q[:, :, 1], sub_k2).astype(jnp.float32)
    v1, i1 = lax.top_k(s1, PEER_TOPK)
    v2, i2 = lax.top_k(s2, PEER_TOPK)
    cand = (v1[..., :, None] + v2[..., None, :]).reshape(T, PEER_HEADS, PEER_TOPK * PEER_TOPK)
    cidx = (i1[..., :, None] * PEER_NKEYS + i2[..., None, :]).reshape(T, PEER_HEADS, PEER_TOPK * PEER_TOPK)
    sc, pick = lax.top_k(cand, PEER_TOPK)
    eidx = jnp.take_along_axis(cidx, pick, axis=-1)
    gate = jax.nn.softmax(sc, axis=-1)
    E = PEER_HEADS * PEER_TOPK
    n_blk = T // PEER_TBLOCK
    xb = cf.reshape(n_blk, PEER_TBLOCK, D)
    ib = eidx.reshape(n_blk, PEER_TBLOCK, E)
    gb = gate.reshape(n_blk, PEER_TBLOCK, E).astype(c.dtype)

    def one_block(args):
        xblk, iblk, gblk = args
        u = u_tab[iblk]
        h = jax.nn.gelu(jnp.einsum('td,ted->te', xblk, u), approximate=False)
        return jnp.einsum('te,ted->td', h * gblk, v_tab[iblk])

    return lax.map(one_block, (xb, ib, gb)).reshape(B, S, D)


def setup_inputs(seed: int = 0) -> dict:
    key = jax.random.key(seed)
    ks = jax.random.split(key, 24)

    def nrm(k, shape, scale):
        return jax.random.normal(k, shape, jnp.float32) * scale

    d = NSA_HEAD_DIM
    return {
        'x': nrm(ks[0], (BATCH, SEQ, D_MODEL), 1.0),
        'attn_norm': 1.0 + nrm(ks[1], (DEPTH, D_MODEL), 0.01),
        'w_in': nrm(ks[2], (DEPTH, D_MODEL, IN_COLS), D_MODEL ** -0.5),
        'da_lambda_q1': nrm(ks[3], (DEPTH, DA_HEAD_DIM), 0.1),
        'da_lambda_k1': nrm(ks[4], (DEPTH, DA_HEAD_DIM), 0.1),
        'da_lambda_q2': nrm(ks[5], (DEPTH, DA_HEAD_DIM), 0.1),
        'da_lambda_k2': nrm(ks[6], (DEPTH, DA_HEAD_DIM), 0.1),
        'da_subln': 1.0 + nrm(ks[7], (DEPTH, DA_V_DIM), 0.01),
        'cmp_pe_k': nrm(ks[8], (DEPTH, CMP_BLOCK, d), 0.1),
        'cmp_pe_v': nrm(ks[9], (DEPTH, CMP_BLOCK, d), 0.1),
        'cmp_w1_k': nrm(ks[10], (DEPTH, CMP_BLOCK * d, d), (CMP_BLOCK * d) ** -0.5),
        'cmp_w1_v': nrm(ks[11], (DEPTH, CMP_BLOCK * d, d), (CMP_BLOCK * d) ** -0.5),
        'cmp_w2_k': nrm(ks[12], (DEPTH, d, d), d ** -0.5),
        'cmp_w2_v': nrm(ks[13], (DEPTH, d, d), d ** -0.5),
        'p_da': nrm(ks[14], (DEPTH, DA_WIDTH, D_MODEL), DA_WIDTH ** -0.5),
        'p_nsa': nrm(ks[15], (DEPTH, NSA_WIDTH, D_MODEL), NSA_WIDTH ** -0.5),
        'w_o': nrm(ks[16], (DEPTH, D_MODEL, D_MODEL), D_MODEL ** -0.5),
        'ffn_norm': 1.0 + nrm(ks[17], (DEPTH, D_MODEL), 0.01),
        'peer_wq': nrm(ks[18], (DEPTH, D_MODEL, PEER_HEADS * PEER_DQ), D_MODEL ** -0.5),
        'peer_k1': nrm(ks[19], (DEPTH, PEER_NKEYS, PEER_DQ // 2), (PEER_DQ // 2) ** -0.5),
        'peer_k2': nrm(ks[20], (DEPTH, PEER_NKEYS, PEER_DQ // 2), (PEER_DQ // 2) ** -0.5),
        'peer_u': nrm(ks[21], (DEPTH, N_EXPERTS, D_MODEL), D_MODEL ** -0.5),
        'peer_v': nrm(ks[22], (DEPTH, N_EXPERTS, D_MODEL), PEER_HEADS ** -0.5),
        'final_norm': 1.0 + nrm(ks[23], (D_MODEL,), 0.01),
    }


def reference(x, attn_norm, w_in, da_lambda_q1, da_lambda_k1, da_lambda_q2, da_lambda_k2, da_subln,
              cmp_pe_k, cmp_pe_v, cmp_w1_k, cmp_w1_v, cmp_w2_k, cmp_w2_v, p_da, p_nsa, w_o,
              ffn_norm, peer_wq, peer_k1, peer_k2, peer_u, peer_v, final_norm):
    h = x
    for l in range(DEPTH):
        lambda_init = 0.8 - 0.6 * math.exp(-0.3 * l)
        a = rmsnorm(h, attn_norm[l])
        h = h + hybrid_mixer(a, w_in[l], da_lambda_q1[l], da_lambda_k1[l], da_lambda_q2[l], da_lambda_k2[l],
                             da_subln[l], lambda_init, cmp_pe_k[l], cmp_pe_v[l], cmp_w1_k[l], cmp_w1_v[l],
                             cmp_w2_k[l], cmp_w2_v[l], p_da[l], p_nsa[l], w_o[l])
        c = rmsnorm(h, ffn_norm[l])
        h = h + peer(c, peer_wq[l], peer_k1[l], peer_k2[l], peer_u[l], peer_v[l])
    return rmsnorm(h, final_norm)
```

```cpp
#include <hip/hip_runtime.h>
#include <hip/hip_cooperative_groups.h>
#include <hip/hip_bf16.h>
#include <cstdio>
#include <cstdint>
#include <cmath>
namespace cg = cooperative_groups;
namespace pg8 {
#define PG8_LAS __attribute__((address_space(3)))
typedef unsigned short bf16_t;
typedef short bf16x8 __attribute__((ext_vector_type(8)));
typedef float f32x4 __attribute__((ext_vector_type(4)));
typedef unsigned u32x4 __attribute__((ext_vector_type(4)));
constexpr int BM = 256, BK = 64, HALF = 128, HTB = HALF * BK * 2  , STAGE_BYTES = 8 * HTB, NXCD = 8, WGM = 8;

__host__ __device__ __forceinline__ int lds_byte(int r, int c) { const int st = (r >> 4) * 2 + (c >> 5), rr = r & 15, cc = c & 31, ob = rr * 64 + cc * 2; return st * 1024 + (ob ^ (((ob >> 9) & 1) << 5)); }
__host__ __device__ __forceinline__ void stage_rc(int b, int& R, int& C) { const int st = b / 1024, sb = b % 1024, swz = sb ^ (((sb >> 9) & 1) << 5); R = (st >> 1) * 16 + swz / 64; C = (st & 1) * 32 + (swz % 64) / 2; }
__host__ __device__ __forceinline__ int perm32(int rho) { const int n = rho >> 4, i = rho & 15; return 8 * (i >> 2) + 4 * n + (i & 3); }

struct Unit { int pm, pn; };
struct Gemm { const bf16_t* A; const bf16_t* Bt; int M, N, K; };

struct StaticOrder {
    int nM, nN, nwg, G, c;
    __host__ __device__ void init(int M, int N, int G_, int c_) { nM = M / BM; nN = N / BM; nwg = nM * nN; G = G_; c = c_; }
    __host__ __device__ bool next(int i, Unit& u) const {
        const long L = (long)i * G + c; if (L >= nwg) return false;
        int wgid = (int)L; { const int q = nwg / NXCD, r = nwg % NXCD, xcd = wgid % NXCD, off = wgid / NXCD; wgid = (xcd < r ? xcd * (q + 1) : r * (q + 1) + (xcd - r) * q) + off; }
        const int nig = WGM * nN, gid = wgid / nig, fm = gid * WGM, gsz = (nM - fm) < WGM ? (nM - fm) : WGM;
        u.pm = fm + ((wgid % nig) % gsz); u.pn = (wgid % nig) / gsz; return true;
    }
    __device__ __forceinline__ void a_ready(const Unit&) const {}
    __device__ __forceinline__ void done(const Unit&) const {}
};

__device__ __forceinline__ unsigned cvt_pk_bf16(float lo, float hi) { unsigned r; asm volatile("v_cvt_pk_bf16_f32 %0, %1, %2" : "=v"(r) : "v"(lo), "v"(hi)); return r; }
typedef float f32x2 __attribute__((ext_vector_type(2)));
typedef int i32x4 __attribute__((ext_vector_type(4)));
template <class Epi, class Sched, bool ALIGN_EPI = false, bool SP2 = false, bool I8 = false>
__device__ __forceinline__ void gemm_phase(PG8_LAS unsigned char* lds, const Gemm g, const Sched& S, const Epi& E) {
    const int tid = threadIdx.x, wid = __builtin_amdgcn_readfirstlane(tid >> 6), lane = tid & 63, wr = wid >> 2, wc = wid & 3, fr = lane & 15, fq = lane >> 4;
    const int K = g.K, nt = K / BK;
    unsigned voffA[2], voffB[2];
#pragma unroll
    for (int i = 0; i < 2; ++i) { int R, C; stage_rc(tid * 16 + i * 8192, R, C); const int Rb = Epi::PERM ? ((R & ~31) + perm32(R & 31)) : R;
        voffA[i] = (unsigned)(R * K + C) * 2u; voffB[i] = (unsigned)(Rb * K + C) * 2u; }
    const size_t kstep = (size_t)(BK * 2);
    const size_t hstep = (size_t)HALF * K * 2;
    const size_t tstep = 2 * hstep;
    const unsigned ldsw = (unsigned)wid * 1024u;
    const int aoff = lds_byte(wr * 64 + fr, fq * 8), boff = lds_byte(wc * 32 + fr, fq * 8);
#define PG8_SA(b, h) (((b) * 2 + (h)) * HTB)
#define PG8_SB(b, h) ((4 + (b) * 2 + (h)) * HTB)
#define PG8_STAGE(bufoff, gbase, voff) do { _Pragma("unroll") for (int _i = 0; _i < 2; ++_i) \
        __builtin_amdgcn_global_load_lds((const unsigned*)((const char*)(gbase) + (voff)[_i]), (PG8_LAS unsigned*)(lds + (bufoff) + ldsw + _i * 8192), 16, 0, 0); } while (0)
#define PG8_LDA(dst, b, h) do { _Pragma("unroll") for (int m = 0; m < 4; ++m) _Pragma("unroll") for (int k = 0; k < 2; ++k) dst[m][k] = *(const PG8_LAS bf16x8*)(lds + PG8_SA(b, h) + aoff + m * 2048 + k * 1024); } while (0)
#define PG8_LDB(dst, b, h) do { _Pragma("unroll") for (int n = 0; n < 2; ++n) _Pragma("unroll") for (int k = 0; k < 2; ++k) dst[n][k] = *(const PG8_LAS bf16x8*)(lds + PG8_SB(b, h) + boff + n * 2048 + k * 1024); } while (0)
#define PG8_MMA(ai, bj, At, Bt) do { __builtin_amdgcn_s_setprio(1); _Pragma("unroll") for (int m = 0; m < 4; ++m) _Pragma("unroll") for (int n = 0; n < 2; ++n) _Pragma("unroll") for (int k = 0; k < 2; ++k) { \
        if constexpr (I8) acc[ai][bj][m][n] = __builtin_bit_cast(f32x4, __builtin_amdgcn_mfma_i32_16x16x64_i8(__builtin_bit_cast(i32x4, Bt[n][k]), __builtin_bit_cast(i32x4, At[m][k]), __builtin_bit_cast(i32x4, acc[ai][bj][m][n]), 0, 0, 0)); \
        else acc[ai][bj][m][n] = __builtin_amdgcn_mfma_f32_16x16x32_bf16(Bt[n][k], At[m][k], acc[ai][bj][m][n], 0, 0, 0); } __builtin_amdgcn_s_setprio(0); } while (0)
#define PG8_WAIT_V(n) asm volatile("s_waitcnt vmcnt(" #n ")" ::: "memory")
#define PG8_WAIT_L(n) asm volatile("s_waitcnt lgkmcnt(" #n ")" ::: "memory")
#define PG8_BAR __builtin_amdgcn_s_barrier()
#define PG8_SCHED __builtin_amdgcn_sched_barrier(0)
    Unit cur, nxt; int ui = 0;
    if (!S.next(0, cur)) return;
    f32x4 acc[2][2][4][2];
#pragma unroll
    for (int a = 0; a < 2; ++a)
#pragma unroll
        for (int b = 0; b < 2; ++b)
#pragma unroll
            for (int m = 0; m < 4; ++m)
#pragma unroll
                for (int n = 0; n < 2; ++n) acc[a][b][m][n] = (f32x4){0.f, 0.f, 0.f, 0.f};
    bf16x8 At[4][2], B0[2][2], B1[2][2];
    const char* cA = (const char*)g.A + (size_t)cur.pm * tstep; const char* cB = (const char*)g.Bt + (size_t)cur.pn * tstep;
    S.a_ready(cur);
    if constexpr (SP2) {
        PG8_STAGE(PG8_SB(0, 0), cB, voffB); PG8_STAGE(PG8_SB(0, 1), cB + hstep, voffB); PG8_STAGE(PG8_SA(0, 0), cA, voffA); PG8_STAGE(PG8_SA(0, 1), cA + hstep, voffA);
        if (wr == 1) PG8_BAR;
        PG8_WAIT_V(2); PG8_BAR;
        PG8_STAGE(PG8_SB(1, 0), cB + kstep, voffB); PG8_STAGE(PG8_SA(1, 0), cA + kstep, voffA); PG8_STAGE(PG8_SB(1, 1), cB + hstep + kstep, voffB);
        PG8_WAIT_V(6); PG8_BAR;
    } else {
        PG8_STAGE(PG8_SB(0, 0), cB, voffB); PG8_STAGE(PG8_SA(0, 0), cA, voffA); PG8_STAGE(PG8_SB(0, 1), cB + hstep, voffB); PG8_STAGE(PG8_SA(0, 1), cA + hstep, voffA);
        if (wr == 1) PG8_BAR;
        PG8_WAIT_V(4); PG8_BAR;
        PG8_STAGE(PG8_SB(1, 0), cB + kstep, voffB); PG8_STAGE(PG8_SA(1, 0), cA + kstep, voffA); PG8_STAGE(PG8_SB(1, 1), cB + hstep + kstep, voffB);
        PG8_WAIT_V(6); PG8_BAR;
    }
    for (;;) {
        const bool has_next = S.next(ui + 1, nxt);
        const char* nA = has_next ? (const char*)g.A + (size_t)nxt.pm * tstep : cA; const char* nB = has_next ? (const char*)g.Bt + (size_t)nxt.pn * tstep : cB;
        for (int t = 0; t < nt; t += 2) {
            const bool last = (t == nt - 2);
            const char* a1 = cA + (size_t)(t + 1) * kstep;
            const char* a2 = last ? nA : cA + (size_t)(t + 2) * kstep; const char* b2 = last ? nB : cB + (size_t)(t + 2) * kstep;
            const char* a3 = a2 + kstep; const char* b3 = b2 + kstep;
            if (last && has_next) S.a_ready(nxt);
            if constexpr (SP2) {
            PG8_LDB(B0, 0, 0); PG8_LDB(B1, 0, 1); PG8_SCHED; PG8_LDA(At, 0, 0); PG8_STAGE(PG8_SA(1, 1), a1 + hstep, voffA);
            PG8_WAIT_V(8); PG8_WAIT_L(0); PG8_BAR; PG8_MMA(0, 0, At, B0); PG8_MMA(0, 1, At, B1); PG8_BAR; PG8_SCHED;
            PG8_LDA(At, 0, 1); PG8_STAGE(PG8_SB(0, 0), b2, voffB); PG8_STAGE(PG8_SB(0, 1), b2 + hstep, voffB); PG8_STAGE(PG8_SA(0, 0), a2, voffA);
            PG8_WAIT_V(8); PG8_WAIT_L(0); PG8_BAR; PG8_MMA(1, 0, At, B0); PG8_MMA(1, 1, At, B1); PG8_BAR; PG8_SCHED;
            PG8_LDB(B0, 1, 0); PG8_LDB(B1, 1, 1); PG8_SCHED; PG8_LDA(At, 1, 0); PG8_STAGE(PG8_SA(0, 1), a2 + hstep, voffA);
            PG8_WAIT_V(8); PG8_WAIT_L(0); PG8_BAR; PG8_MMA(0, 0, At, B0); PG8_MMA(0, 1, At, B1); PG8_BAR; PG8_SCHED;
            PG8_LDA(At, 1, 1); PG8_STAGE(PG8_SB(1, 0), b3, voffB); PG8_STAGE(PG8_SB(1, 1), b3 + hstep, voffB); PG8_STAGE(PG8_SA(1, 0), a3, voffA);
            PG8_WAIT_V(8); PG8_WAIT_L(0); PG8_BAR; PG8_MMA(1, 0, At, B0); PG8_MMA(1, 1, At, B1); PG8_BAR; PG8_SCHED;
            } else {
            PG8_LDB(B0, 0, 0); PG8_SCHED; PG8_LDA(At, 0, 0); PG8_STAGE(PG8_SA(1, 1), a1 + hstep, voffA);
            PG8_WAIT_L(8); PG8_BAR; PG8_WAIT_L(0); PG8_MMA(0, 0, At, B0); PG8_BAR; PG8_SCHED;
            PG8_LDB(B1, 0, 1); PG8_STAGE(PG8_SB(0, 0), b2, voffB);
            PG8_BAR; PG8_WAIT_L(0); PG8_MMA(0, 1, At, B1); PG8_BAR;
            PG8_LDA(At, 0, 1); PG8_STAGE(PG8_SA(0, 0), a2, voffA);
            PG8_BAR; PG8_WAIT_L(0); PG8_MMA(1, 0, At, B0); PG8_BAR; PG8_SCHED;
            PG8_STAGE(PG8_SB(0, 1), b2 + hstep, voffB);
            PG8_WAIT_V(6); PG8_BAR; PG8_MMA(1, 1, At, B1); PG8_BAR;
            PG8_LDB(B0, 1, 0); PG8_SCHED; PG8_LDA(At, 1, 0); PG8_STAGE(PG8_SA(0, 1), a2 + hstep, voffA);
            PG8_WAIT_L(8); PG8_BAR; PG8_WAIT_L(0); PG8_MMA(0, 0, At, B0); PG8_BAR; PG8_SCHED;
            PG8_LDB(B1, 1, 1); PG8_STAGE(PG8_SB(1, 0), b3, voffB);
            PG8_BAR; PG8_WAIT_L(0); PG8_MMA(0, 1, At, B1); PG8_BAR;
            PG8_LDA(At, 1, 1); PG8_STAGE(PG8_SA(1, 0), a3, voffA);
            PG8_BAR; PG8_WAIT_L(0); PG8_MMA(1, 0, At, B0); PG8_BAR; PG8_SCHED;
            PG8_STAGE(PG8_SB(1, 1), b3 + hstep, voffB);
            PG8_WAIT_V(6); PG8_BAR; PG8_MMA(1, 1, At, B1); PG8_BAR;
            }
        }
        if constexpr (ALIGN_EPI) { if (wr == 0) PG8_BAR; }
        if constexpr (!Epi::AFTER_DRAIN) { E(acc, cur, wr, wc, fr, fq); S.done(cur); }
        if (!has_next) break;
#pragma unroll
        for (int a = 0; a < 2; ++a)
#pragma unroll
            for (int b = 0; b < 2; ++b)
#pragma unroll
                for (int m = 0; m < 4; ++m)
#pragma unroll
                    for (int n = 0; n < 2; ++n) acc[a][b][m][n] = (f32x4){0.f, 0.f, 0.f, 0.f};
        cur = nxt; cA = nA; cB = nB; ++ui;
        if constexpr (ALIGN_EPI) { if (wr == 1) PG8_BAR; }
    }
    PG8_WAIT_V(0);
    if constexpr (!ALIGN_EPI) { if (wr == 0) PG8_BAR; }
    PG8_BAR;
    if constexpr (Epi::AFTER_DRAIN) { E.fused(acc, cur, wr, wc, fr, fq, lds, wid, lane); S.done(cur); }
#undef PG8_SA
#undef PG8_SB
#undef PG8_STAGE
#undef PG8_LDA
#undef PG8_LDB
#undef PG8_MMA
#undef PG8_WAIT_V
#undef PG8_WAIT_L
#undef PG8_BAR
#undef PG8_SCHED
}
}

#define LAS __attribute__((address_space(3)))
typedef unsigned short bf16_t;
typedef short bf16x8 __attribute__((ext_vector_type(8)));
typedef short s16x4 __attribute__((ext_vector_type(4)));
typedef float f32x4 __attribute__((ext_vector_type(4)));
typedef float f32x2 __attribute__((ext_vector_type(2)));
typedef float f32x16 __attribute__((ext_vector_type(16)));
typedef unsigned u32x4 __attribute__((ext_vector_type(4)));
typedef unsigned u32x2 __attribute__((ext_vector_type(2)));
typedef __bf16 bf16x2_t __attribute__((ext_vector_type(2)));
typedef _Float16 f16x2_t __attribute__((ext_vector_type(2)));

#ifndef ENABLE_NSA
#define ENABLE_NSA 1
#endif
#ifndef ENABLE_PEER
#define ENABLE_PEER 1
#endif
#ifndef PEER_SIMPLE_REDUCE
#define PEER_SIMPLE_REDUCE 0
#endif
#ifndef PEER_CHECK
#define PEER_CHECK 0
#endif
#ifndef PEER_MANUAL_DOT
#define PEER_MANUAL_DOT 1
#endif
#ifndef REPEAT_PH
#define REPEAT_PH 0
#endif
#ifndef USE_XCD_BARRIER
#define USE_XCD_BARRIER 1
#endif
#ifndef TS_PROBE
#define TS_PROBE -1
#endif
#ifndef PROBE_P7
#define PROBE_P7 0
#endif
#ifndef REPEAT_LAUNCH
#define REPEAT_LAUNCH -1
#endif
#ifndef MFMA_NIBSWAP
#define MFMA_NIBSWAP 0
#endif
#ifndef MFMA_DEBUG
#define MFMA_DEBUG 0
#endif
#ifndef ALT_VAL
#define ALT_VAL 1
#endif
#ifndef UBENCH
#define UBENCH 0
#endif
#ifndef N_LAUNCH_MODE
#define N_LAUNCH_MODE 1
#endif

constexpr int NB = 8, SEQ = 4096, DM = 1024, NT = NB * SEQ;
constexpr int IN_COLS = 4888, NPAD = 5120, ZP = 2816;
constexpr int NEXP = 16384;
constexpr float RMS_EPS = 1e-6f;
constexpr float C2 = 0.125f * 1.4426950408889634f;
constexpr float LAMBDA_INIT = 0.2f;
constexpr int ZC_QDA = 0, ZC_KDA = 512, ZC_VDA = 1024, ZC_QN = 1536, ZC_KC = 2048, ZC_VC = 2176, ZC_KS = 2304, ZC_VS = 2432, ZC_KW = 2560, ZC_VW = 2688;

constexpr size_t MiB = 1u << 20;
constexpr size_t WS_BAR = 0;
constexpr size_t WS_ROPE = 1 * MiB;
constexpr size_t WS_MISC = 2 * MiB;
constexpr size_t WS_SS = 3 * MiB;
constexpr size_t WS_WIN_T = 8 * MiB;
constexpr size_t WS_PDA_T = 18 * MiB;
constexpr size_t WS_PNSA_T = 19 * MiB;
constexpr size_t WS_WO_T = 20 * MiB;
constexpr size_t WS_WP_T = 22 * MiB;
constexpr size_t WS_CW1_T = 26 * MiB;
constexpr size_t WS_CW2_T = 26 * MiB + 512 * 1024;
constexpr size_t WS_KC = 27 * MiB;
constexpr size_t WS_GN = 28 * MiB;
constexpr size_t WS_UT = 32 * MiB;
constexpr size_t WS_CMAX = 64 * 1024;
constexpr size_t WS_WSC = 5 * MiB;
constexpr size_t WS_ASC = 6 * MiB;
constexpr size_t WS_TSC = 4 * MiB;
constexpr size_t WS_A = 96 * MiB;
constexpr size_t WS_YDA = 96 * MiB, WS_YN = 128 * MiB;
constexpr size_t WS_GM = 160 * MiB;
constexpr size_t WS_SC = 160 * MiB;
constexpr size_t WS_ZA = 288 * MiB;
constexpr size_t WS_TMP = 288 * MiB, WS_MERGED = 352 * MiB, WS_HG = 416 * MiB;
constexpr size_t WS_END = 480 * MiB;

constexpr int LDS_BYTES = 147456;
constexpr int NWAVES = 8;

__device__ __forceinline__ unsigned pk_bf16(float lo, float hi) { f32x2 v = {lo, hi}; bf16x2_t b = __builtin_convertvector(v, bf16x2_t); return __builtin_bit_cast(unsigned, b); }
__device__ __forceinline__ unsigned pk_f16(float lo, float hi) { f32x2 v = {lo, hi}; f16x2_t b = __builtin_convertvector(v, f16x2_t); return __builtin_bit_cast(unsigned, b); }
__device__ __forceinline__ float bf_lo(unsigned u) { return __builtin_bit_cast(float, u << 16); }
__device__ __forceinline__ float bf_hi(unsigned u) { return __builtin_bit_cast(float, u & 0xffff0000u); }

__device__ __forceinline__ float sigmoidf_(float x) { return __builtin_amdgcn_rcpf(1.0f + __expf(-x)); }
__device__ __forceinline__ float gelu_erf(float v) { return 0.5f * v * (1.0f + erff(v * 0.70710678118654752f)); }
__device__ __forceinline__ float gelu_poly(float v) {
    const float av = fabsf(v), t = __builtin_amdgcn_rcpf(av * 0.2316418882f + 1.0f);
    float q = t * 0.5307027145f + (-0.7265760135f); q = q * t + 0.7107068705f; q = q * t + (-0.142248368f); q = q * t + 0.127414796f; q = q * t;
    const float e = __builtin_amdgcn_exp2f((v * v) * (-0.72134752044f));
    const float m = v * (q * e), r = v - m;
    return v < 0.f ? m : r;
}
__device__ __forceinline__ float swap32_other(float x) {
    auto rr = __builtin_amdgcn_permlane32_swap(__float_as_uint(x), __float_as_uint(x), false, false);
    return (threadIdx.x & 32) ? __uint_as_float(rr[0]) : __uint_as_float(rr[1]);
}
template <int CTRL> __device__ __forceinline__ float dppf(float x) { return __int_as_float(__builtin_amdgcn_mov_dpp(__float_as_int(x), CTRL, 0xF, 0xF, true)); }
template <int CTRL> __device__ __forceinline__ unsigned dppu(unsigned x) { return (unsigned)__builtin_amdgcn_mov_dpp((int)x, CTRL, 0xF, 0xF, true); }
constexpr int DPP_XOR1 = 0xB1, DPP_XOR2 = 0x4E, DPP_HMIRROR = 0x141, DPP_MIRROR = 0x140, DPP_ROR8 = 0x128;
__device__ __forceinline__ float swz16f(float x) { return __int_as_float(__builtin_amdgcn_ds_swizzle(__float_as_int(x), 0x401F)); }
__device__ __forceinline__ unsigned swz16u(unsigned x) { return (unsigned)__builtin_amdgcn_ds_swizzle((int)x, 0x401F); }
__device__ __forceinline__ float row16_sum(float v) { v += dppf<DPP_XOR1>(v); v += dppf<DPP_XOR2>(v); v += dppf<DPP_HMIRROR>(v); v += dppf<DPP_MIRROR>(v); return v; }
__device__ __forceinline__ float wave_max(float v) { v = fmaxf(v, dppf<DPP_XOR1>(v)); v = fmaxf(v, dppf<DPP_XOR2>(v)); v = fmaxf(v, dppf<DPP_HMIRROR>(v)); v = fmaxf(v, dppf<DPP_MIRROR>(v)); v = fmaxf(v, swz16f(v)); v = fmaxf(v, swap32_other(v)); return v; }
__device__ __forceinline__ float wave_sum(float v) { v = row16_sum(v); v += swz16f(v); v += swap32_other(v); return v; }
__device__ __forceinline__ unsigned row16_maxu(unsigned v) { unsigned t;
    t = dppu<DPP_XOR1>(v); v = v > t ? v : t; t = dppu<DPP_XOR2>(v); v = v > t ? v : t; t = dppu<DPP_HMIRROR>(v); v = v > t ? v : t; t = dppu<DPP_MIRROR>(v); v = v > t ? v : t; return v; }

struct Params {
    const float* in[24]; float* out; unsigned char* ws; int ph_lo, ph_hi, alt, pad;
};

struct EpiInProj {
    static constexpr bool PERM = true, AFTER_DRAIN = false;
    bf16_t* ZA; bf16_t* GM; float* GN; const float* rope; int plain; const float* asc; const float* wsc;
    __device__ __forceinline__ void operator()(const f32x4 (&acc)[2][2][4][2], const pg8::Unit& u, int wr, int wc, int fr, int fq) const {
        const int pn = u.pn;
        const bool is_rope_lane = ((wc & 1) == 0) && (fq < 2);
        const float sgn = (fq == 0) ? -1.f : 1.f;
#pragma unroll
        for (int ai = 0; ai < 2; ++ai) {
            f32x4 rpv[4][4];
#pragma unroll
            for (int m = 0; m < 4; ++m) {
                if ((m & 1) == 0 && pn <= 10 && is_rope_lane && !plain) {
#pragma unroll
                    for (int mm = m; mm < m + 2; ++mm) {
                        const int pos = (u.pm * 256 + ai * 128 + wr * 64 + mm * 16 + fr) & (SEQ - 1);
                        const f32x4* rp = (const f32x4*)(rope + (size_t)pos * 16);
                        rpv[mm][0] = rp[0]; rpv[mm][1] = rp[1]; rpv[mm][2] = rp[2]; rpv[mm][3] = rp[3];
                    }
                }
                const int row = u.pm * 256 + ai * 128 + wr * 64 + m * 16 + fr;
                const float ra = asc[row];
#pragma unroll
                for (int bj = 0; bj < 2; ++bj) {
                    const int ct = bj * 128 + wc * 32 + fq * 8;
                    float v[8];
                    const f32x4 ws0 = *(const f32x4*)(wsc + pn * 256 + ct), ws1 = *(const f32x4*)(wsc + pn * 256 + ct + 4);
#pragma unroll
                    for (int i = 0; i < 4; ++i) { v[i] = (float)__float_as_int(acc[ai][bj][m][0][i]) * (ra * ws0[i]); v[4 + i] = (float)__float_as_int(acc[ai][bj][m][1][i]) * (ra * ws1[i]); }
                    if (pn <= 10) {
                        const bool rope_tile = (pn < 4) || (pn == 6) || (pn == 7) || (pn >= 8 && bj == 0);
                        if (rope_tile && !plain) {
                            float pv[8];
#pragma unroll
                            for (int i = 0; i < 8; ++i) pv[i] = swz16f(v[i]);
                            if (is_rope_lane) {
                                const f32x4 c0 = rpv[m][0], c1 = rpv[m][1], s0 = rpv[m][2], s1 = rpv[m][3];
#pragma unroll
                                for (int i = 0; i < 4; ++i) { v[i] = v[i] * c0[i] + sgn * pv[i] * s0[i]; v[4 + i] = v[4 + i] * c1[i] + sgn * pv[4 + i] * s1[i]; }
                            }
                        }
                        const float sc = (pn < 2 || pn == 6 || pn == 7) ? C2 : 1.0f;
                        u32x4 w; w.x = pk_bf16(v[0] * sc, v[1] * sc); w.y = pk_bf16(v[2] * sc, v[3] * sc); w.z = pk_bf16(v[4] * sc, v[5] * sc); w.w = pk_bf16(v[6] * sc, v[7] * sc);
                        *(u32x4*)(ZA + (size_t)row * ZP + pn * 256 + ct) = w;
                    } else if (pn <= 18) {
                        if (!plain) {
#pragma unroll
                        for (int i = 0; i < 8; ++i) v[i] = sigmoidf_(v[i]);
                        }
                        u32x4 w; w.x = pk_bf16(v[0], v[1]); w.y = pk_bf16(v[2], v[3]); w.z = pk_bf16(v[4], v[5]); w.w = pk_bf16(v[6], v[7]);
                        *(u32x4*)(GM + (size_t)row * 2048 + (pn - 11) * 256 + ct) = w;
                    } else {
                        if (bj == 0 && wc == 0) {
                            f32x4 a = {sigmoidf_(v[0]), sigmoidf_(v[1]), sigmoidf_(v[2]), sigmoidf_(v[3])}, b = {sigmoidf_(v[4]), sigmoidf_(v[5]), sigmoidf_(v[6]), sigmoidf_(v[7])};
                            *(f32x4*)(GN + (size_t)row * 32 + fq * 8) = a; *(f32x4*)(GN + (size_t)row * 32 + fq * 8 + 4) = b;
                        }
                    }
                }
            }
        }
    }
};
template <int SECOND> struct EpiGate {
    static constexpr bool PERM = true, AFTER_DRAIN = false;
    const bf16_t* GM; bf16_t* TMP; bf16_t* OUT;
    __device__ __forceinline__ void operator()(const f32x4 (&acc)[2][2][4][2], const pg8::Unit& u, int wr, int wc, int fr, int fq) const {
#pragma unroll
        for (int ai = 0; ai < 2; ++ai) {
            u32x4 gv[4][2], tv[4][2];
#pragma unroll
            for (int m = 0; m < 4; ++m)
#pragma unroll
                for (int bj = 0; bj < 2; ++bj) {
                    const int row = u.pm * 256 + ai * 128 + wr * 64 + m * 16 + fr, col = u.pn * 256 + bj * 128 + wc * 32 + fq * 8;
                    gv[m][bj] = *(const u32x4*)(GM + (size_t)row * 2048 + SECOND * 1024 + col);
                    if (SECOND) tv[m][bj] = *(const u32x4*)(TMP + (size_t)row * 1024 + col);
                }
#pragma unroll
            for (int m = 0; m < 4; ++m)
#pragma unroll
                for (int bj = 0; bj < 2; ++bj) {
                    const int row = u.pm * 256 + ai * 128 + wr * 64 + m * 16 + fr, col = u.pn * 256 + bj * 128 + wc * 32 + fq * 8;
                    const u32x4 g = gv[m][bj];
                    float v[8];
#pragma unroll
                    for (int i = 0; i < 4; ++i) { v[i] = acc[ai][bj][m][0][i]; v[4 + i] = acc[ai][bj][m][1][i]; }
                    v[0] *= bf_lo(g.x); v[1] *= bf_hi(g.x); v[2] *= bf_lo(g.y); v[3] *= bf_hi(g.y); v[4] *= bf_lo(g.z); v[5] *= bf_hi(g.z); v[6] *= bf_lo(g.w); v[7] *= bf_hi(g.w);
                    if (SECOND) {
                        const u32x4 t = tv[m][bj];
                        v[0] += bf_lo(t.x); v[1] += bf_hi(t.x); v[2] += bf_lo(t.y); v[3] += bf_hi(t.y); v[4] += bf_lo(t.z); v[5] += bf_hi(t.z); v[6] += bf_lo(t.w); v[7] += bf_hi(t.w);
                    }
                    u32x4 w; w.x = pk_bf16(v[0], v[1]); w.y = pk_bf16(v[2], v[3]); w.z = pk_bf16(v[4], v[5]); w.w = pk_bf16(v[6], v[7]);
                    *(u32x4*)(OUT + (size_t)row * 1024 + col) = w;
                }
        }
    }
};
struct EpiWo {
    static constexpr bool PERM = true, AFTER_DRAIN = false;
    const float* X; bf16_t* HB; float* ss;
    __device__ __forceinline__ void operator()(const f32x4 (&acc)[2][2][4][2], const pg8::Unit& u, int wr, int wc, int fr, int fq) const {
#pragma unroll
        for (int ai = 0; ai < 2; ++ai) {
            f32x4 xv[4][2][2];
#pragma unroll
            for (int m = 0; m < 4; ++m)
#pragma unroll
                for (int bj = 0; bj < 2; ++bj) {
                    const int row = u.pm * 256 + ai * 128 + wr * 64 + m * 16 + fr, col = u.pn * 256 + bj * 128 + wc * 32 + fq * 8;
                    xv[m][bj][0] = *(const f32x4*)(X + (size_t)row * DM + col); xv[m][bj][1] = *(const f32x4*)(X + (size_t)row * DM + col + 4);
                }
#pragma unroll
            for (int m = 0; m < 4; ++m) {
                const int row = u.pm * 256 + ai * 128 + wr * 64 + m * 16 + fr;
                float sq = 0.f;
#pragma unroll
                for (int bj = 0; bj < 2; ++bj) {
                    const int col = u.pn * 256 + bj * 128 + wc * 32 + fq * 8;
                    const f32x4 h0 = xv[m][bj][0] + acc[ai][bj][m][0], h1 = xv[m][bj][1] + acc[ai][bj][m][1];
                    sq += (h0[0] * h0[0] + h0[1] * h0[1]) + (h0[2] * h0[2] + h0[3] * h0[3]) + (h1[0] * h1[0] + h1[1] * h1[1]) + (h1[2] * h1[2] + h1[3] * h1[3]);
                    u32x4 w; w.x = pk_bf16(h0[0], h0[1]); w.y = pk_bf16(h0[2], h0[3]); w.z = pk_bf16(h1[0], h1[1]); w.w = pk_bf16(h1[2], h1[3]);
                    *(u32x4*)(HB + (size_t)row * DM + col) = w;
                }
                sq += __shfl_xor(sq, 16); sq += __shfl_xor(sq, 32);
                if (fq == 0) atomicAdd(ss + row, sq);
            }
        }
    }
};
struct EpiScores {
    static constexpr bool PERM = true, AFTER_DRAIN = false;
    const float* ss; unsigned short* SC;
    __device__ __forceinline__ void operator()(const f32x4 (&acc)[2][2][4][2], const pg8::Unit& u, int wr, int wc, int fr, int fq) const {
        float ssv[2][4];
#pragma unroll
        for (int ai = 0; ai < 2; ++ai)
#pragma unroll
            for (int m = 0; m < 4; ++m) ssv[ai][m] = ss[u.pm * 256 + ai * 128 + wr * 64 + m * 16 + fr];
#pragma unroll
        for (int ai = 0; ai < 2; ++ai)
#pragma unroll
            for (int m = 0; m < 4; ++m) {
                const int row = u.pm * 256 + ai * 128 + wr * 64 + m * 16 + fr;
                const float rs = rsqrtf(ssv[ai][m] * (1.0f / DM) + RMS_EPS);
#pragma unroll
                for (int bj = 0; bj < 2; ++bj) {
                    const int col = u.pn * 256 + bj * 128 + wc * 32 + fq * 8;
                    const f32x4 a = acc[ai][bj][m][0] * rs, b = acc[ai][bj][m][1] * rs;
                    u32x4 w; w.x = pk_f16(a[0], a[1]); w.y = pk_f16(a[2], a[3]); w.z = pk_f16(b[0], b[1]); w.w = pk_f16(b[2], b[3]);
                    *(u32x4*)(SC + (size_t)row * 2048 + col) = w;
                }
            }
    }
};

template <int NR>
__device__ __forceinline__ void convert_table_rows(const Params& P, int rr0, int lane) {
    unsigned char* ws = P.ws;
    f32x4 a[NR][4]; float ss[NR];
    f32x4 gq[4];
#pragma unroll
    for (int q = 0; q < 4; ++q) gq[q] = *(const f32x4*)(P.in[17] + lane * 16 + 4 * q);
#pragma unroll
    for (int u = 0; u < NR; ++u) {
        const int rr = rr0 + u, tbl = rr >= NEXP ? 1 : 0, r = rr - tbl * NEXP;
        const f32x4* sp = (const f32x4*)(P.in[21 + tbl] + (size_t)r * DM + lane * 16);
#pragma unroll
        for (int q = 0; q < 4; ++q) a[u][q] = tbl ? sp[q] : sp[q] * gq[q];
    }
#pragma unroll
    for (int u = 0; u < NR; ++u) { ss[u] = 0.f;
#pragma unroll
        for (int q = 0; q < 4; ++q) ss[u] += (a[u][q][0] * a[u][q][0] + a[u][q][1] * a[u][q][1]) + (a[u][q][2] * a[u][q][2] + a[u][q][3] * a[u][q][3]); }
#pragma unroll
    for (int u = 0; u < NR; ++u) {
        const int rr = rr0 + u, tbl = rr >= NEXP ? 1 : 0, r = rr - tbl * NEXP;
        const float rms = sqrtf(wave_sum(ss[u]) * (1.0f / DM));
        const float sc = (tbl ? 0.5f : 0.335f) * rms + 1e-30f, inv = 1.0f / sc;
        u32x2 o;
#pragma unroll
        for (int h = 0; h < 2; ++h) {
            unsigned w = 0u;
            if (tbl) {
                w = __builtin_amdgcn_cvt_scalef32_pk_fp4_f32(w, a[u][2 * h][0] * inv, a[u][2 * h][1] * inv, 1.0f, 0);
                w = __builtin_amdgcn_cvt_scalef32_pk_fp4_f32(w, a[u][2 * h][2] * inv, a[u][2 * h][3] * inv, 1.0f, 1);
                w = __builtin_amdgcn_cvt_scalef32_pk_fp4_f32(w, a[u][2 * h + 1][0] * inv, a[u][2 * h + 1][1] * inv, 1.0f, 2);
                w = __builtin_amdgcn_cvt_scalef32_pk_fp4_f32(w, a[u][2 * h + 1][2] * inv, a[u][2 * h + 1][3] * inv, 1.0f, 3);
            } else {
#pragma unroll
                for (int i = 0; i < 8; ++i) {
                    int q = (int)floorf(a[u][2 * h + (i >> 2)][i & 3] * inv);
                    q = q < -8 ? -8 : (q > 7 ? 7 : q);
                    w |= ((unsigned)q & 15u) << (4 * i);
                }
            }
            o[h] = w;
        }
        ((u32x2*)(ws + WS_UT) + tbl)[((size_t)r * 64 + lane) * 2] = o;
        if (lane == 0) ((float*)(ws + WS_TSC) + tbl * NEXP)[r] = sc;
    }
}
struct TableOrder : pg8::StaticOrder {
    const Params* P; int gw; mutable int calls;
    __device__ __forceinline__ void done(const pg8::Unit&) const {
        const int slot = gw * 4 + calls; ++calls;
        if (calls <= 4) convert_table_rows<4>(*P, slot * 4, (int)(threadIdx.x & 63));
    }
};
__device__ __forceinline__ int remap_win(int n) { return n < 2816 ? n : (n < 2840 ? 4864 + (n - 2816) : n - 24); }
template <int MODE>
__device__ __forceinline__ void transpose_item(const float* W, int K, int N, bf16_t* WT, LAS float* scr, int item, int lane, const unsigned* cmax = nullptr, float* wsc = nullptr) {
    const int nblk = (N + 31) / 32, kb = item / nblk, nb = item % nblk, k0 = 64 * kb, n0 = 32 * nb;
    const int nn = n0 + (lane & 31);
#pragma unroll 8
    for (int i = 0; i < 32; ++i) { const int kk = 2 * i + (lane >> 5); scr[kk * 33 + (lane & 31)] = (nn < N) ? W[(size_t)(k0 + kk) * N + nn] : 0.f; }
    asm volatile("s_waitcnt lgkmcnt(0)" ::: "memory");
    const int c = lane & 7;
#pragma unroll
    for (int j = 0; j < 4; ++j) {
        const int n = (lane >> 3) + 8 * j; const LAS float* s = scr + (8 * c) * 33 + n;
        u32x4 o; o.x = pk_bf16(s[0 * 33], s[1 * 33]); o.y = pk_bf16(s[2 * 33], s[3 * 33]); o.z = pk_bf16(s[4 * 33], s[5 * 33]); o.w = pk_bf16(s[6 * 33], s[7 * 33]);
        if constexpr (MODE == 2) {
            if (n0 + n < N) {
                const float cm = __uint_as_float(cmax[n0 + n]), sc = cm > 0.f ? 127.0f / cm : 0.f;
                unsigned w0 = 0u, w1 = 0u;
#pragma unroll
                for (int e = 0; e < 4; ++e) { const int q0 = (int)rintf(s[e * 33] * sc), q1 = (int)rintf(s[(4 + e) * 33] * sc); w0 |= ((unsigned)q0 & 255u) << (8 * e); w1 |= ((unsigned)q1 & 255u) << (8 * e); }
                const int dst = remap_win(n0 + n);
                *(u32x2*)((unsigned char*)WT + (size_t)dst * K + k0 + 8 * c) = (u32x2){w0, w1};
                if (k0 == 0 && c == 0) wsc[dst] = cm * (1.0f / 127.0f);
            }
        } else
        if (n0 + n < N) { const int dst = MODE == 1 ? remap_win(n0 + n) : (n0 + n); *(u32x4*)(WT + (size_t)dst * K + k0 + 8 * c) = o; }
    }
    asm volatile("s_waitcnt lgkmcnt(0)" ::: "memory");
}

__device__ __forceinline__ void p0_prep(const Params& P, LAS unsigned char* lds, int gw, int NGW, int wave, int lane, int part) {
    unsigned char* ws = P.ws;
    LAS float* scr = (LAS float*)(lds + wave * 16384);
    if (part == 0) {
        {
            constexpr int NB = (IN_COLS + 31) / 32;
            unsigned* cmax = (unsigned*)(ws + WS_CMAX);
            for (int it = gw; it < 16 * NB; it += NGW) {
                const int kb = it / NB, nb = it % NB, nn = 32 * nb + (lane & 31);
                const float* wp = P.in[2] + (size_t)(64 * kb + (lane >> 5)) * IN_COLS + nn;
                float mx = 0.f;
                if (nn < IN_COLS) {
#pragma unroll 8
                    for (int i = 0; i < 32; ++i) mx = fmaxf(mx, fabsf(wp[(size_t)(2 * i) * IN_COLS]));
                }
                mx = fmaxf(mx, swap32_other(mx));
                if (lane < 32 && nn < IN_COLS) atomicMax(cmax + nn, __float_as_uint(mx));
            }
        }
        return;
    }
    {
        constexpr int I_WIN = (1024 / 64) * ((IN_COLS + 31) / 32);
        for (int it = gw; it < I_WIN; it += NGW) transpose_item<2>(P.in[2], 1024, IN_COLS, (bf16_t*)(ws + WS_WIN_T), scr, it, lane, (const unsigned*)(ws + WS_CMAX), (float*)(ws + WS_WSC));
        u32x4* z = (u32x4*)(ws + WS_WIN_T + (size_t)IN_COLS * 1024);
        const int n16 = (NPAD - IN_COLS) * 1024 / 16;
        for (int i = gw * 64 + lane; i < n16; i += NGW * 64) z[i] = (u32x4){0u, 0u, 0u, 0u};
        if (gw == 0) for (int i = IN_COLS + lane; i < NPAD; i += 64) ((float*)(ws + WS_WSC))[i] = 0.f;
    }
    {
        constexpr int I_P = (512 / 64) * (1024 / 32), I_WO = (1024 / 64) * (1024 / 32), I_C1 = (2048 / 64) * (64 / 32), I_C2 = 1 * 2;
        constexpr int NITEMS = 2 * I_P + I_WO + 2 * I_C1 + 2 * I_C2;
        for (int it = gw; it < NITEMS; it += NGW) {
            int r = it;
            if (r < I_P) { transpose_item<0>(P.in[14], 512, 1024, (bf16_t*)(ws + WS_PDA_T), scr, r, lane); continue; } r -= I_P;
            if (r < I_P) { transpose_item<0>(P.in[15], 512, 1024, (bf16_t*)(ws + WS_PNSA_T), scr, r, lane); continue; } r -= I_P;
            if (r < I_WO) { transpose_item<0>(P.in[16], 1024, 1024, (bf16_t*)(ws + WS_WO_T), scr, r, lane); continue; } r -= I_WO;
            if (r < I_C1) { transpose_item<0>(P.in[10], 2048, 64, (bf16_t*)(ws + WS_CW1_T), scr, r, lane); continue; } r -= I_C1;
            if (r < I_C1) { transpose_item<0>(P.in[11], 2048, 64, (bf16_t*)(ws + WS_CW1_T) + 64 * 2048, scr, r, lane); continue; } r -= I_C1;
            if (r < I_C2) { transpose_item<0>(P.in[12], 64, 64, (bf16_t*)(ws + WS_CW2_T), scr, r, lane); continue; } r -= I_C2;
            transpose_item<0>(P.in[13], 64, 64, (bf16_t*)(ws + WS_CW2_T) + 64 * 64, scr, r, lane);
        }
    }
    {
        const float* wq = P.in[18]; bf16_t* WPT = (bf16_t*)(ws + WS_WP_T);
        const int i = lane & 31, kh = lane >> 5;
        for (int task = gw; task < 32 * 64; task += NGW) {
            const int jt = task >> 6, nt = task & 63, j0 = jt * 32, n0 = nt * 32;
            const int c = (n0 >> 7) & 1, k0 = n0 & 127, hc_off = n0 & ~127;
            const float* sk = c ? P.in[20] : P.in[19];
            const float* ap = wq + (size_t)(j0 + i) * 2048 + hc_off + 4 * kh;
            const float gj = P.in[17][j0 + i];
            const float* bp = sk + (size_t)(k0 + i) * 128 + 4 * kh;
            f32x16 acc = {0};
#pragma unroll 4
            for (int u = 0; u < 16; ++u) {
                const f32x4 a4 = *(const f32x4*)(ap + 8 * u) * gj, b4 = *(const f32x4*)(bp + 8 * u);
#pragma unroll
                for (int e = 0; e < 4; ++e) acc = __builtin_amdgcn_mfma_f32_32x32x2f32(a4[e], b4[e], acc, 0, 0, 0);
            }
#pragma unroll
            for (int g = 0; g < 4; ++g) {
                u32x2 o; o.x = pk_bf16(acc[4 * g + 0], acc[4 * g + 1]); o.y = pk_bf16(acc[4 * g + 2], acc[4 * g + 3]);
                *(u32x2*)(WPT + (size_t)(n0 + i) * 1024 + j0 + 8 * g + 4 * kh) = o;
            }
        }
    }
    {
        float* rope = (float*)(ws + WS_ROPE);
        for (int idx = gw * 64 + lane; idx < SEQ * 8; idx += NGW * 64) {
            const int pos = idx >> 3, i = idx & 7;
            const float inv = (float)pow(500000.0, -(double)i / 8.0);
            const float ang = (float)pos * inv;
            rope[pos * 16 + i] = (float)cos((double)ang); rope[pos * 16 + 8 + i] = (float)sin((double)ang);
        }
    }
    {
        float* misc = (float*)(ws + WS_MISC);
        for (int task = gw; task < 128; task += NGW) {
            const int t = task >> 6, n = task & 63; const float* pe = P.in[8 + t]; const float* w1 = P.in[10 + t];
            float s = 0.f;
            for (int kk = lane; kk < 2048; kk += 64) s += pe[kk] * w1[(size_t)kk * 64 + n];
            s = wave_sum(s);
            if (lane == 0) misc[64 + task] = s;
        }
        if (gw == 0) {
            float a = P.in[3][lane] * P.in[4][lane], b = P.in[5][lane] * P.in[6][lane];
            a = wave_sum(a); b = wave_sum(b);
            if (lane == 0) misc[0] = __expf(a) - __expf(b) + LAMBDA_INIT;
        }
        float* ss = (float*)(ws + WS_SS);
        for (int i = gw * 64 + lane; i < NT; i += NGW * 64) ss[i] = 0.f;
    }
    {
        const float* gn = P.in[1]; bf16_t* A = (bf16_t*)(ws + WS_A);
        f32x4 g[4];
#pragma unroll
        for (int j = 0; j < 4; ++j) g[j] = ((const f32x4*)gn)[64 * j + lane];
        for (int mrow = gw; mrow < NT; mrow += 2 * NGW) {
            const f32x4* xr0 = (const f32x4*)(P.in[0] + (size_t)mrow * DM) + lane; const f32x4* xr1 = (const f32x4*)(P.in[0] + (size_t)(mrow + NGW) * DM) + lane;
            f32x4 v0[4], v1[4]; float s0 = 0.f, s1 = 0.f;
#pragma unroll
            for (int j = 0; j < 4; ++j) { v0[j] = xr0[64 * j]; v1[j] = xr1[64 * j]; }
#pragma unroll
            for (int j = 0; j < 4; ++j) { s0 += (v0[j][0] * v0[j][0] + v0[j][1] * v0[j][1]) + (v0[j][2] * v0[j][2] + v0[j][3] * v0[j][3]); s1 += (v1[j][0] * v1[j][0] + v1[j][1] * v1[j][1]) + (v1[j][2] * v1[j][2] + v1[j][3] * v1[j][3]); }
            const float rs0 = rsqrtf(wave_sum(s0) * (1.0f / DM) + RMS_EPS), rs1 = rsqrtf(wave_sum(s1) * (1.0f / DM) + RMS_EPS);
            float m0 = 0.f, m1 = 0.f;
#pragma unroll
            for (int j = 0; j < 4; ++j)
#pragma unroll
                for (int e = 0; e < 4; ++e) { v0[j][e] *= rs0 * g[j][e]; v1[j][e] *= rs1 * g[j][e]; m0 = fmaxf(m0, fabsf(v0[j][e])); m1 = fmaxf(m1, fabsf(v1[j][e])); }
            m0 = wave_max(m0); m1 = wave_max(m1);
            const float q0 = m0 > 0.f ? 127.0f / m0 : 0.f, q1 = m1 > 0.f ? 127.0f / m1 : 0.f;
            unsigned* o0 = (unsigned*)((unsigned char*)A + (size_t)mrow * DM) + lane; unsigned* o1 = (unsigned*)((unsigned char*)A + (size_t)(mrow + NGW) * DM) + lane;
#pragma unroll
            for (int j = 0; j < 4; ++j) {
                unsigned a = 0u, b = 0u;
#pragma unroll
                for (int e = 0; e < 4; ++e) { a |= ((unsigned)(int)rintf(v0[j][e] * q0) & 255u) << (8 * e); b |= ((unsigned)(int)rintf(v1[j][e] * q1) & 255u) << (8 * e); }
                o0[64 * j] = a; o1[64 * j] = b;
            }
            if (lane == 0) { ((float*)(ws + WS_ASC))[mrow] = m0 * (1.0f / 127.0f); ((float*)(ws + WS_ASC))[mrow + NGW] = m1 * (1.0f / 127.0f); }
        }
    }
}

__device__ __forceinline__ void compress_tasks(const Params& P, LAS unsigned char* lds, int wgid, int wave, int lane) {
    unsigned char* ws = P.ws;
    const bf16_t* ZA = (const bf16_t*)(ws + WS_ZA);
    const float* misc = (const float*)(ws + WS_MISC);
    typedef float f32x4v __attribute__((ext_vector_type(4)));
    const int task = 2 * wgid + (wave >> 2), kch = wave & 3;
    const int t = task >> 8, rem = task & 255, b = rem >> 5, g = (rem >> 4) & 1, nt = rem & 15;
    const int m = lane & 15, q = lane >> 4;
    const int n = nt * 16 + m, ne = n < 255 ? n : 254;
    const bf16_t* W1T = (const bf16_t*)(ws + WS_CW1_T) + (size_t)t * 64 * 2048;
    const bf16_t* src = ZA + (size_t)(b * SEQ + 16 * ne) * ZP + (t ? ZC_VC : ZC_KC) + g * 64;
    f32x4v d1[4];
#pragma unroll
    for (int i = 0; i < 4; ++i) d1[i] = (f32x4v){0.f, 0.f, 0.f, 0.f};
    if (task < 512) {
        bf16x8 fb[16];
#pragma unroll
        for (int kk = 0; kk < 16; ++kk) { const int k = kch * 512 + kk * 32 + 8 * q; fb[kk] = *(const bf16x8*)(src + (size_t)(k >> 6) * ZP + (k & 63)); }
#pragma unroll
        for (int kk = 0; kk < 16; ++kk) {
            const int k = kch * 512 + kk * 32 + 8 * q;
#pragma unroll
            for (int t4 = 0; t4 < 4; ++t4) {
                const bf16x8 wa = *(const bf16x8*)(W1T + (size_t)(16 * t4 + m) * 2048 + k);
                d1[t4] = __builtin_amdgcn_mfma_f32_16x16x32_bf16(wa, fb[kk], d1[t4], 0, 0, 0);
            }
        }
    }
    LAS float* part = (LAS float*)lds;
#pragma unroll
    for (int t4 = 0; t4 < 4; ++t4)
#pragma unroll
        for (int r = 0; r < 4; ++r) part[(wave * 16 + t4 * 4 + r) * 64 + lane] = d1[t4][r];
    __syncthreads();
    if (kch == 0 && task < 512) {
        const int w0 = wave;
        float gl[4][4];
#pragma unroll
        for (int t4 = 0; t4 < 4; ++t4)
#pragma unroll
            for (int r = 0; r < 4; ++r) {
                float s = 0.f;
#pragma unroll
                for (int w = 0; w < 4; ++w) s += part[((w0 + w) * 16 + t4 * 4 + r) * 64 + lane];
                s += misc[64 + t * 64 + 16 * t4 + 4 * q + r];
                gl[t4][r] = gelu_poly(s);
            }
        const bf16_t* W2T = (const bf16_t*)(ws + WS_CW2_T) + (size_t)t * 64 * 64;
        f32x4v d2[4];
#pragma unroll
        for (int i = 0; i < 4; ++i) d2[i] = (f32x4v){0.f, 0.f, 0.f, 0.f};
#pragma unroll
        for (int s = 0; s < 2; ++s) {
            u32x4 bw; bw.x = pk_bf16(gl[2 * s][0], gl[2 * s][1]); bw.y = pk_bf16(gl[2 * s][2], gl[2 * s][3]); bw.z = pk_bf16(gl[2 * s + 1][0], gl[2 * s + 1][1]); bw.w = pk_bf16(gl[2 * s + 1][2], gl[2 * s + 1][3]);
            const bf16x8 gb = __builtin_bit_cast(bf16x8, bw);
#pragma unroll
            for (int t2 = 0; t2 < 4; ++t2) {
                const bf16_t* wp = W2T + (size_t)(16 * t2 + m) * 64 + 32 * s + 4 * q;
                const u32x2 lo = *(const u32x2*)wp, hi = *(const u32x2*)(wp + 16);
                u32x4 aw; aw.x = lo.x; aw.y = lo.y; aw.z = hi.x; aw.w = hi.y;
                d2[t2] = __builtin_amdgcn_mfma_f32_16x16x32_bf16(__builtin_bit_cast(bf16x8, aw), gb, d2[t2], 0, 0, 0);
            }
        }
        bf16_t* KC = (bf16_t*)(ws + WS_KC) + (size_t)t * (NB * 2 * 256 * 64) + (size_t)((b * 2 + g) * 256 + n) * 64;
#pragma unroll
        for (int t2 = 0; t2 < 4; ++t2) {
            u32x2 o; o.x = pk_bf16(d2[t2][0], d2[t2][1]); o.y = pk_bf16(d2[t2][2], d2[t2][3]);
            if (n >= 255) { o.x = 0u; o.y = 0u; }
            *(u32x2*)(KC + 16 * t2 + 4 * q) = o;
        }
    }
    __syncthreads();
}

namespace att {
constexpr int K_BYTES = 8192, V_BYTES = 16384;
constexpr int OFF_RING = 0;
constexpr int OFF_K0 = 0;
constexpr int OFF_WSF = 73728;
constexpr int OFF_IMP = OFF_WSF + NWAVES * 64 * 4;
constexpr int OFF_SELM = OFF_IMP + 4 * 64 * 65 * 4;
constexpr int OFF_END = OFF_SELM + 512;
static_assert(OFF_END <= LDS_BYTES - 256, "attention LDS map");
__device__ __forceinline__ int crow(int r, int hi) { return (r & 3) + 8 * (r >> 2) + 4 * hi; }
typedef short v4i16_t __attribute__((ext_vector_type(4)));
__device__ __forceinline__ s16x4 vtr(const LAS unsigned char* p) { return __builtin_bit_cast(s16x4, __builtin_amdgcn_ds_read_tr16_b64_v4i16((LAS v4i16_t*)p)); }

template <int NDB> struct Stage { u32x4 k; u32x4 v[NDB / 2]; };
template <int NDB>
__device__ __forceinline__ void stage_load(Stage<NDB>& s, const bf16_t* Kg, const bf16_t* Vg, int pitch, int j, int tid) {
    const int key = tid >> 3, ch = tid & 7;
    s.k = *(const u32x4*)(Kg + (size_t)(j * 64 + key) * pitch + ch * 8);
    if constexpr (NDB == 2) { s.v[0] = *(const u32x4*)(Vg + (size_t)(j * 64 + key) * pitch + ch * 8); }
    else {
#pragma unroll
        for (int p = 0; p < 2; ++p) { const int row = p * 32 + (tid >> 4), c16 = tid & 15; s.v[p] = *(const u32x4*)(Vg + (size_t)(j * 64 + row) * pitch + c16 * 8); }
    }
}
template <int NDB>
__device__ __forceinline__ void stage_store(const Stage<NDB>& s, LAS unsigned char* Kb, LAS unsigned char* Vb, int tid) {
    const int key = tid >> 3, ch = tid & 7;
    *(LAS u32x4*)(Kb + ch * 1024 + ((key ^ ch) << 4)) = s.k;
    if constexpr (NDB == 2) { *(LAS u32x4*)(Vb + (ch >> 2) * 4096 + (key >> 4) * 1024 + (key & 15) * 64 + (ch & 3) * 16) = s.v[0]; }
    else {
#pragma unroll
        for (int p = 0; p < 2; ++p) { const int row = p * 32 + (tid >> 4), c16 = tid & 15; *(LAS u32x4*)(Vb + (c16 >> 2) * 4096 + (row >> 4) * 1024 + (row & 15) * 64 + (c16 & 3) * 16) = s.v[p]; }
    }
}
__device__ __forceinline__ void tile_scores(f32x16& p0, f32x16& p1, const LAS unsigned char* Kb, const bf16x8 (&qr)[4], int kvbase, int lob, int hib, int lane) {
    const int r32 = lane & 31, hi = lane >> 5;
    p0 = (f32x16){0.f}; p1 = (f32x16){0.f};
    bf16x8 kf0[4], kf1[4];
#pragma unroll
    for (int d0 = 0; d0 < 4; ++d0) {
        const int c = 2 * d0 + hi;
        const LAS unsigned char* kp = Kb + c * 1024 + ((r32 ^ c) << 4);
        kf0[d0] = *(const LAS bf16x8*)kp; kf1[d0] = *(const LAS bf16x8*)(kp + 512);
    }
    __builtin_amdgcn_sched_barrier(0);
#pragma unroll
    for (int d0 = 0; d0 < 4; ++d0) {
        p0 = __builtin_amdgcn_mfma_f32_32x32x16_bf16(kf0[d0], qr[d0], p0, 0, 0, 0);
        p1 = __builtin_amdgcn_mfma_f32_32x32x16_bf16(kf1[d0], qr[d0], p1, 0, 0, 0);
    }
    const bool allv = (kvbase + 63 <= hib) && (kvbase > lob);
    if (!__all(allv)) {
#pragma unroll
        for (int r = 0; r < 16; ++r) {
            const int kv = kvbase + crow(r, hi);
            if (kv > hib || kv <= lob) p0[r] = -INFINITY;
            if (kv + 32 > hib || kv + 32 <= lob) p1[r] = -INFINITY;
        }
    }
}
__device__ __forceinline__ float max3f(float a, float b, float c) { return __builtin_fmaxf(__builtin_fmaxf(a, b), c); }
__device__ __forceinline__ float rowmax32(const f32x16& p0, const f32x16& p1) {
    float a = max3f(p0[0], p0[1], p1[0]), b = max3f(p0[2], p0[3], p1[1]); a = max3f(a, p1[2], p1[3]);
#pragma unroll
    for (int r = 4; r < 16; r += 4) { a = max3f(a, p0[r], p0[r + 1]); b = max3f(b, p0[r + 2], p0[r + 3]); a = max3f(a, p1[r], p1[r + 1]); b = max3f(b, p1[r + 2], p1[r + 3]); }
    a = __builtin_fmaxf(a, b);
    return __builtin_fmaxf(a, swap32_other(a));
}
template <int NDB>
__device__ __forceinline__ void tile_compute(const LAS unsigned char* Kb, const LAS unsigned char* Vb, const bf16x8 (&qr)[4], float& m, float& l, f32x16 (&o)[NDB], LAS float* wsf, int kvbase, int lob, int hib, int lane, bool lanesel = true) {
    const int hi = lane >> 5, r32 = lane & 31;
    f32x16 p0, p1;
    tile_scores(p0, p1, Kb, qr, kvbase, lob, hib, lane);
    const float rm = lanesel ? rowmax32(p0, p1) : -INFINITY;
    const float mn = fmaxf(m, rm);
    if (__any(mn > m + 8.0f)) {
        const float alpha = __builtin_amdgcn_exp2f(m - mn);
        l *= alpha; m = mn;
        if (hi == 0) wsf[r32] = alpha;
#pragma unroll
        for (int g = 0; g < 4; ++g) {
            const f32x4 a4 = *(const LAS f32x4*)(wsf + 8 * g + 4 * hi);
#pragma unroll
            for (int db = 0; db < NDB; ++db) { o[db][4 * g + 0] *= a4[0]; o[db][4 * g + 1] *= a4[1]; o[db][4 * g + 2] *= a4[2]; o[db][4 * g + 3] *= a4[3]; }
        }
    }
    {
        const float msub = lanesel ? m : INFINITY;
        const f32x2 m2 = {msub, msub};
        f32x2 sa = {0.f, 0.f}, sb = {0.f, 0.f};
#pragma unroll
        for (int r = 0; r < 16; r += 2) {
            f32x2 t0 = (f32x2){p0[r], p0[r + 1]} - m2, t1 = (f32x2){p1[r], p1[r + 1]} - m2;
            t0.x = __builtin_amdgcn_exp2f(t0.x); t0.y = __builtin_amdgcn_exp2f(t0.y); t1.x = __builtin_amdgcn_exp2f(t1.x); t1.y = __builtin_amdgcn_exp2f(t1.y);
            sa += t0; sb += t1;
            p0[r] = t0.x; p0[r + 1] = t0.y; p1[r] = t1.x; p1[r + 1] = t1.y;
        }
        sa += sb;
        l += sa.x + sa.y;
    }
    u32x4 pw[4];
#pragma unroll
    for (int k = 0; k < 2; ++k) {
        pw[k] = (u32x4){pk_bf16(p0[8 * k + 0], p0[8 * k + 1]), pk_bf16(p0[8 * k + 2], p0[8 * k + 3]), pk_bf16(p0[8 * k + 4], p0[8 * k + 5]), pk_bf16(p0[8 * k + 6], p0[8 * k + 7])};
        pw[2 + k] = (u32x4){pk_bf16(p1[8 * k + 0], p1[8 * k + 1]), pk_bf16(p1[8 * k + 2], p1[8 * k + 3]), pk_bf16(p1[8 * k + 4], p1[8 * k + 5]), pk_bf16(p1[8 * k + 6], p1[8 * k + 7])};
    }
    const LAS unsigned char* vp = Vb + ((lane >> 4) & 1) * 32 + (lane & 3) * 8 + (4 * hi + ((lane & 15) >> 2)) * 64;
    s16x4 vlo[2][4], vhh[2][4];
#pragma unroll
    for (int ks = 0; ks < 4; ++ks) { vlo[0][ks] = vtr(vp + ks * 1024); vhh[0][ks] = vtr(vp + ks * 1024 + 512); }
#pragma unroll
    for (int db = 0; db < NDB; ++db) {
        if (NDB == 4 && db + 1 < NDB) {
#pragma unroll
            for (int ks = 0; ks < 4; ++ks) { vlo[(db + 1) & 1][ks] = vtr(vp + (db + 1) * 4096 + ks * 1024); vhh[(db + 1) & 1][ks] = vtr(vp + (db + 1) * 4096 + ks * 1024 + 512); }
        }
        if (NDB != 4 && db > 0) {
#pragma unroll
            for (int ks = 0; ks < 4; ++ks) { vlo[db & 1][ks] = vtr(vp + db * 4096 + ks * 1024); vhh[db & 1][ks] = vtr(vp + db * 4096 + ks * 1024 + 512); }
        }
        __builtin_amdgcn_sched_barrier(0);
#pragma unroll
        for (int ks = 0; ks < 4; ++ks) {
            const s16x4 lo = vlo[db & 1][ks], hh = vhh[db & 1][ks];
            const bf16x8 vf = (bf16x8){lo[0], lo[1], lo[2], lo[3], hh[0], hh[1], hh[2], hh[3]};
            o[db] = __builtin_amdgcn_mfma_f32_32x32x16_bf16(__builtin_bit_cast(bf16x8, pw[ks]), vf, o[db], 0, 0, 0);
        }
        __builtin_amdgcn_sched_barrier(0);
    }
}
__device__ __forceinline__ void glds16(const bf16_t* gsrc, LAS unsigned char* lds_dst) {
    unsigned keep; const unsigned dst = (unsigned)__builtin_amdgcn_readfirstlane((int)(unsigned)(size_t)lds_dst);
    asm volatile("s_mov_b32 %0, m0\n\ts_mov_b32 m0, %2\n\ts_nop 0\n\tglobal_load_lds_dwordx4 %1, off\n\ts_mov_b32 m0, %0" : "=&s"(keep) : "v"(gsrc), "s"(dst) : "memory");
}
#define ATT_WAIT_BAR(N) asm volatile("s_waitcnt vmcnt(" #N ") lgkmcnt(0)\n\ts_barrier" ::: "memory")
template <int NDB, bool SEL>
__device__ __forceinline__ void stream(LAS unsigned char* lds, const bf16_t* Kg, const bf16_t* Vg, int pitch, int ntiles, int j0, unsigned long long tilemask, unsigned long long mymask, int lob, int hib,
                                       const bf16x8 (&qr)[4], float& m, float& l, f32x16 (&o)[NDB], LAS float* wsf, int tid, int lane, int wave) {
    constexpr int SLOT = K_BYTES + NDB * 4096;
    const bf16_t* ksrc = Kg + (size_t)(lane ^ wave) * pitch + wave * 8;
    const bf16_t* vsrc0 = Vg + (size_t)(16 * (wave & 3) + (lane >> 2)) * pitch + (wave >> 2) * 32 + (lane & 3) * 8;
    const size_t tstep = (size_t)64 * pitch;
    auto issue = [&](int j, int slot) {
        LAS unsigned char* base = lds + OFF_RING + slot * SLOT;
        glds16(ksrc + (size_t)j * tstep, base + wave * 1024);
        glds16(vsrc0 + (size_t)j * tstep, base + K_BYTES + wave * 1024);
        if constexpr (NDB == 4) glds16(vsrc0 + (size_t)j * tstep + 64, base + K_BYTES + (wave + 8) * 1024);
    };
    unsigned long long rem = tilemask;
    int jseq = j0;
    auto nextj = [&]() -> int { if constexpr (SEL) { const int j = __ffsll((long long)rem) - 1; rem &= rem - 1; return j; } else { return jseq++; } };
    asm volatile("s_waitcnt vmcnt(0)" ::: "memory");
    int jc = nextj(), jn = 0;
    issue(jc, 0);
    if (ntiles > 1) { jn = nextj(); issue(jn, 1); }
    if (ntiles > 1) { if constexpr (NDB == 4) ATT_WAIT_BAR(3); else ATT_WAIT_BAR(2); } else ATT_WAIT_BAR(0);
    int hib_min = hib;
    if constexpr (SEL) { hib_min = __builtin_amdgcn_readfirstlane(hib - (lane & 31)); }
    int slot = 0;
#pragma nounroll
    for (int i = 0; i < ntiles; ++i) {
        int jn2 = 0;
        const bool more2 = i + 2 < ntiles;
        if (more2) { jn2 = nextj(); issue(jn2, slot == 0 ? 2 : slot - 1); }
        const LAS unsigned char* Kb = lds + OFF_RING + slot * SLOT;
        if constexpr (SEL) {
            const bool sel = ((mymask >> jc) & 1ull) != 0ull;
            if (jc * 64 + 63 <= hib_min) tile_compute<NDB>(Kb, Kb + K_BYTES, qr, m, l, o, wsf, jc * 64, lob, 0x7fffffff, lane, sel);
            else tile_compute<NDB>(Kb, Kb + K_BYTES, qr, m, l, o, wsf, jc * 64, lob, sel ? hib : -1, lane);
        } else {
            tile_compute<NDB>(Kb, Kb + K_BYTES, qr, m, l, o, wsf, jc * 64, lob, hib, lane);
        }
        if (more2) { if constexpr (NDB == 4) ATT_WAIT_BAR(3); else ATT_WAIT_BAR(2); } else ATT_WAIT_BAR(0);
        jc = jn; jn = jn2; slot = slot == 2 ? 0 : slot + 1;
    }
}
template <int NDB>
__device__ __forceinline__ void fold(f32x16 (&acc)[NDB], const f32x16 (&o)[NDB], float coef, LAS float* wsf, int lane, bool first) {
    const int hi = lane >> 5, r32 = lane & 31;
    if (hi == 0) wsf[32 + r32] = coef;
#pragma unroll
    for (int g = 0; g < 4; ++g) {
        const f32x4 c4 = *(const LAS f32x4*)(wsf + 32 + 8 * g + 4 * hi);
#pragma unroll
        for (int db = 0; db < NDB; ++db)
#pragma unroll
            for (int e = 0; e < 4; ++e) acc[db][4 * g + e] = first ? o[db][4 * g + e] * c4[e] : acc[db][4 * g + e] + o[db][4 * g + e] * c4[e];
    }
}
}

__device__ __forceinline__ void da_unit(const Params& P, LAS unsigned char* lds, int b, int h, int qb, int tid, int lane, int wave) {
    asm volatile("" : "+v"(tid), "+v"(lane));
    unsigned char* ws = P.ws;
    const bf16_t* Z = (const bf16_t*)(ws + WS_ZA) + (size_t)b * SEQ * ZP;
    const int r32 = lane & 31, hi = lane >> 5;
    const int q0 = qb * 256, qpos = q0 + wave * 32 + r32;
    LAS float* wsf = (LAS float*)(lds + att::OFF_WSF) + wave * 64;
    const int ntiles = (q0 + 256) / 64;
    unsigned o1p[4][8];
    f32x16 o[4]; float cf[16];
#pragma nounroll
    for (int comp = 0; comp < 2; ++comp) {
        bf16x8 qr[4];
#pragma unroll
        for (int d0 = 0; d0 < 4; ++d0) qr[d0] = *(const bf16x8*)(Z + (size_t)qpos * ZP + ZC_QDA + h * 128 + comp * 64 + d0 * 16 + hi * 8);
        asm volatile("" : "+v"(qr[0]), "+v"(qr[1]), "+v"(qr[2]), "+v"(qr[3]));
        float m = -1e30f, l = 0.f;
#pragma unroll
        for (int i = 0; i < 4; ++i) o[i] = (f32x16){0.f};
        att::stream<4, false>(lds, Z + ZC_KDA + h * 128 + comp * 64, Z + ZC_VDA + h * 128, ZP, ntiles, 0, 0ull, 0ull, -0x7fffffff, qpos, qr, m, l, o, wsf, tid, lane, wave);
        const float lt = l + swap32_other(l);
        const float coef = 1.0f / lt;
        if (hi == 0) wsf[32 + r32] = coef;
#pragma unroll
        for (int g = 0; g < 4; ++g) { const f32x4 c4 = *(const LAS f32x4*)(wsf + 32 + 8 * g + 4 * hi); cf[4 * g] = c4[0]; cf[4 * g + 1] = c4[1]; cf[4 * g + 2] = c4[2]; cf[4 * g + 3] = c4[3]; }
        if (comp == 0) {
#pragma unroll
            for (int db = 0; db < 4; ++db)
#pragma unroll
                for (int r = 0; r < 8; ++r) o1p[db][r] = pk_bf16(o[db][2 * r] * cf[2 * r], o[db][2 * r + 1] * cf[2 * r + 1]);
        }
    }
    const float lam = ((const float*)(ws + WS_MISC))[0];
    const float* subln = P.in[7];
    float sl[4];
#pragma unroll
    for (int db = 0; db < 4; ++db) sl[db] = subln[32 * db + r32] * (1.0f - LAMBDA_INIT);
    bf16_t* Y = (bf16_t*)(ws + WS_YDA) + (size_t)(b * SEQ + q0 + wave * 32 + 4 * hi) * 512 + h * 128 + r32;
    asm volatile("" : "+v"(Y));
#pragma unroll
    for (int r = 0; r < 16; ++r) {
        float v[4];
#pragma unroll
        for (int db = 0; db < 4; ++db) v[db] = ((r & 1) ? bf_hi(o1p[db][r >> 1]) : bf_lo(o1p[db][r >> 1])) - lam * o[db][r] * cf[r];
        float s = v[0] * v[0] + v[1] * v[1] + v[2] * v[2] + v[3] * v[3];
        s = row16_sum(s); s += swz16f(s);
        const float rs = rsqrtf(s * (1.0f / 128.0f) + RMS_EPS);
        const int qrow = (r & 3) + 8 * (r >> 2);
#pragma unroll
        for (int db = 0; db < 4; ++db) ((__attribute__((address_space(1))) bf16_t*)Y)[(size_t)qrow * 512 + 32 * db] = (bf16_t)(pk_bf16(v[db] * rs * sl[db], 0.f) & 0xffffu);
    }
}

__device__ __forceinline__ void nsa_unit(const Params& P, LAS unsigned char* lds, int b, int g, int ib, int tid, int lane, int wave) {
    asm volatile("" : "+v"(tid), "+v"(lane));
    unsigned char* ws = P.ws;
    const bf16_t* Z = (const bf16_t*)(ws + WS_ZA) + (size_t)b * SEQ * ZP;
    const int r32 = lane & 31, hi = lane >> 5;
    const int hh = wave >> 1, head = g * 4 + hh, ql = (wave & 1) * 32 + r32, qpos = ib * 64 + ql;
    LAS float* wsf = (LAS float*)(lds + att::OFF_WSF) + wave * 64;
    LAS float* imp = (LAS float*)(lds + att::OFF_IMP);
    LAS unsigned long long* selm = (LAS unsigned long long*)(lds + att::OFF_SELM);
    const float* gn = (const float*)(ws + WS_GN) + (size_t)(b * SEQ + qpos) * 32 + head * 3;
    float g0 = gn[0], g1 = gn[1], g2 = gn[2];
    asm volatile("" : "+v"(g0), "+v"(g1), "+v"(g2));
    bf16x8 qr[4];
#pragma unroll
    for (int d0 = 0; d0 < 4; ++d0) qr[d0] = *(const bf16x8*)(Z + (size_t)qpos * ZP + ZC_QN + head * 64 + d0 * 16 + hi * 8);
    asm volatile("" : "+v"(qr[0]), "+v"(qr[1]), "+v"(qr[2]), "+v"(qr[3]));
    for (int i = tid; i < 4 * 64 * 65; i += 512) imp[i] = 0.f;
    f32x16 res[2];
    const bf16_t* KC = (const bf16_t*)(ws + WS_KC) + (size_t)((b * 2 + g) * 256) * 64;
    const bf16_t* VC = KC + (size_t)NB * 2 * 256 * 64;
    const int nmax = qpos >= 31 ? (((qpos - 31) >> 4) < 254 ? ((qpos - 31) >> 4) : 254) : -1;
    const int ntc = ((4 * ib + 2) >> 6) + 1;
    float mc, invl;
    {
        float m = -1e30f, l = 0.f; f32x16 o[2]; o[0] = (f32x16){0.f}; o[1] = (f32x16){0.f};
        att::stream<2, false>(lds, KC, VC, 64, ntc, 0, 0ull, 0ull, -0x7fffffff, nmax, qr, m, l, o, wsf, tid, lane, wave);
        const float lt = l + swap32_other(l);
        invl = lt > 0.f ? 1.0f / lt : 0.f; mc = m;
        att::fold<2>(res, o, g0 * invl, wsf, lane, true);
    }
    {
        float carry = 0.f;
        att::Stage<2> st;
        for (int jt = 0; jt < ntc; ++jt) {
            st.k = *(const u32x4*)(KC + (size_t)(jt * 64 + (tid >> 3)) * 64 + (tid & 7) * 8);
            { const int key = tid >> 3, ch = tid & 7; *(LAS u32x4*)(lds + att::OFF_K0 + ch * 1024 + ((key ^ ch) << 4)) = st.k; }
            __syncthreads();
            f32x16 p0, p1;
            att::tile_scores(p0, p1, lds + att::OFF_K0, qr, jt * 64, -0x7fffffff, nmax, lane);
            float G[8], E[8];
#pragma unroll
            for (int kk = 0; kk < 4; ++kk) {
                float a0 = __builtin_amdgcn_exp2f(p0[4 * kk + 0] - mc) * invl, a1 = __builtin_amdgcn_exp2f(p0[4 * kk + 1] - mc) * invl, a2 = __builtin_amdgcn_exp2f(p0[4 * kk + 2] - mc) * invl, a3 = __builtin_amdgcn_exp2f(p0[4 * kk + 3] - mc) * invl;
                G[kk] = (a0 + a1) + (a2 + a3); E[kk] = a3;
                float b0 = __builtin_amdgcn_exp2f(p1[4 * kk + 0] - mc) * invl, b1 = __builtin_amdgcn_exp2f(p1[4 * kk + 1] - mc) * invl, b2 = __builtin_amdgcn_exp2f(p1[4 * kk + 2] - mc) * invl, b3 = __builtin_amdgcn_exp2f(p1[4 * kk + 3] - mc) * invl;
                G[4 + kk] = (b0 + b1) + (b2 + b3); E[4 + kk] = b3;
            }
            float X[8];
#pragma unroll
            for (int kk = 0; kk < 8; ++kk) X[kk] = swap32_other(E[kk]);
#pragma unroll
            for (int kk = 0; kk < 8; ++kk) {
                const float prev = hi ? X[kk] : (kk == 0 ? carry : X[kk - 1]);
                const int s = 16 * jt + 2 * kk + hi;
                imp[(hh * 64 + s) * 65 + ql] = G[kk] + prev;
            }
            carry = X[7];
            __syncthreads();
        }
    }
    __syncthreads();
    {
        const int s = lane;
        const bool valid = s <= ib, forced = (s == 0) || (s == ib) || (s == ib - 1);
#pragma nounroll
        for (int qq = 0; qq < 8; ++qq) {
            const int q = wave * 8 + qq;
            const float v = imp[(0 * 64 + s) * 65 + q] + imp[(1 * 64 + s) * 65 + q] + imp[(2 * 64 + s) * 65 + q] + imp[(3 * 64 + s) * 65 + q];
            bool sel;
            if (ib + 1 <= 16) sel = valid;
            else {
                const bool cand = valid && !forced;
                const unsigned key = cand ? (((__float_as_uint(v) & ~63u) + 64u) | (unsigned)(63 - s)) : 0u;
                LAS unsigned* wsu = (LAS unsigned*)wsf;
                wsu[s] = key;
                int rank = 0;
#pragma unroll
                for (int s4 = 0; s4 < 16; ++s4) {
                    const u32x4 k4 = *(const LAS u32x4*)(wsu + 4 * s4);
#pragma unroll
                    for (int e = 0; e < 4; ++e) rank += (k4[e] > key) ? 1 : 0;
                }
                sel = forced || (cand && rank < 13);
            }
            const unsigned long long mk = __ballot(sel);
            if (lane == 0) selm[q] = mk;
        }
    }
    __syncthreads();
    const unsigned long long mymask = selm[ql];
    unsigned long long uni = 0ull;
    for (int q = 0; q < 64; ++q) uni |= selm[q];
    uni = ((unsigned long long)(unsigned)__builtin_amdgcn_readfirstlane((int)(uni >> 32)) << 32) | (unsigned)__builtin_amdgcn_readfirstlane((int)(uni & 0xffffffffull));
    {
        float m = -1e30f, l = 0.f; f32x16 o[2]; o[0] = (f32x16){0.f}; o[1] = (f32x16){0.f};
        const int nts = __popcll(uni);
        att::stream<2, true>(lds, Z + ZC_KS + g * 64, Z + ZC_VS + g * 64, ZP, nts, 0, uni, mymask, -0x7fffffff, qpos, qr, m, l, o, wsf, tid, lane, wave);
        const float lt = l + swap32_other(l);
        att::fold<2>(res, o, lt > 0.f ? g1 / lt : 0.f, wsf, lane, false);
    }
    {
        float m = -1e30f, l = 0.f; f32x16 o[2]; o[0] = (f32x16){0.f}; o[1] = (f32x16){0.f};
        const int j0 = ib >= 8 ? ib - 8 : 0;
        att::stream<2, false>(lds, Z + ZC_KW + g * 64, Z + ZC_VW + g * 64, ZP, ib - j0 + 1, j0, 0ull, 0ull, qpos - 512, qpos, qr, m, l, o, wsf, tid, lane, wave);
        const float lt = l + swap32_other(l);
        att::fold<2>(res, o, lt > 0.f ? g2 / lt : 0.f, wsf, lane, false);
    }
    bf16_t* Y = (bf16_t*)(ws + WS_YN) + (size_t)(b * SEQ + ib * 64 + (wave & 1) * 32 + 4 * hi) * 512 + head * 64 + r32;
    asm volatile("" : "+v"(Y));
#pragma unroll
    for (int r = 0; r < 16; ++r) {
        const int qrow = (r & 3) + 8 * (r >> 2);
#pragma unroll
        for (int db = 0; db < 2; ++db) ((__attribute__((address_space(1))) bf16_t*)Y)[(size_t)qrow * 512 + 32 * db] = (bf16_t)(pk_bf16(res[db][r], 0.f) & 0xffffu);
    }
    __syncthreads();
}

__device__ __forceinline__ void cswap_desc(unsigned& a, unsigned& b) { const unsigned hi = a > b ? a : b, lo = a > b ? b : a; a = hi; b = lo; }
__device__ __forceinline__ unsigned f16_order(unsigned hb) { return (hb & 0x8000u) ? (~hb & 0xffffu) : (hb | 0x8000u); }
__device__ __forceinline__ float f16_unorder(unsigned ob) { const unsigned hb = (ob & 0x8000u) ? (ob & 0x7fffu) : (~ob & 0xffffu); return (float)__builtin_bit_cast(_Float16, (unsigned short)hb); }
__device__ __forceinline__ unsigned f32_order(float f) { const unsigned u = __float_as_uint(f); return (u & 0x80000000u) ? ~u : (u | 0x80000000u); }

__device__ __forceinline__ void peer_issue(u32x4 (&uv)[16], float& su, float& sv, const unsigned char* UVb, const float* TSC, const LAS unsigned* tabE, int bt, int myslot, unsigned lane16) {
#pragma unroll
    for (int e = 0; e < 16; ++e) { const unsigned off = tabE[bt * 16 + e] + lane16; uv[e] = *(const u32x4*)(UVb + off); }
    const unsigned myidx = tabE[bt * 16 + myslot] >> 10;
    su = TSC[myidx]; sv = TSC[NEXP + myidx];
}
__device__ __forceinline__ float peer_dot(const u32x4 (&uv)[16], float su, float sv, const int (&cH)[2], const int (&cL)[2], float chalf, float rsc, const LAS float* tabG, int bt, int myslot, int lane) {
    float part[16];
#pragma unroll
    for (int e = 0; e < 16; ++e) {
        int ah = __builtin_amdgcn_sdot8((int)uv[e][0], cH[0], 0, false); ah = __builtin_amdgcn_sdot8((int)uv[e][1], cH[1], ah, false);
        int al = __builtin_amdgcn_sdot8((int)uv[e][0], cL[0], 0, false); al = __builtin_amdgcn_sdot8((int)uv[e][1], cL[1], al, false);
        part[e] = (float)(ah * 16 + al);
    }
    float r8[8];
#pragma unroll
    for (int e = 0; e < 8; ++e) {
        auto rr = __builtin_amdgcn_permlane32_swap(__float_as_uint(part[e]), __float_as_uint(part[e + 8]), false, false);
        r8[e] = __uint_as_float(rr[0]) + __uint_as_float(rr[1]);
    }
    const bool b4 = (lane & 16) != 0, b3 = (lane & 8) != 0, b2 = (lane & 4) != 0;
    float r4[4];
#pragma unroll
    for (int e = 0; e < 4; ++e) { const float send = b4 ? r8[e] : r8[e + 4], keep = b4 ? r8[e + 4] : r8[e]; r4[e] = keep + swz16f(send); }
    float r2[2];
#pragma unroll
    for (int e = 0; e < 2; ++e) { const float send = b3 ? r4[e] : r4[e + 2], keep = b3 ? r4[e + 2] : r4[e]; r2[e] = keep + dppf<DPP_ROR8>(send); }
    float r1;
    { const float send = b2 ? r2[0] : r2[1], keep = b2 ? r2[1] : r2[0]; r1 = keep + dppf<DPP_HMIRROR>(send); }
    r1 += dppf<DPP_XOR1>(r1); r1 += dppf<DPP_XOR2>(r1);
    return gelu_poly((r1 + chalf) * rsc * su) * tabG[bt * 16 + myslot] * sv;
}
__device__ __forceinline__ void peer_vphase(const u32x4 (&uv)[16], float hval, f32x4 (&acc)[4]) {
#pragma unroll
    for (int e = 0; e < 16; ++e) {
        const float w = __int_as_float(__builtin_amdgcn_readlane(__float_as_int(hval), e * 4));
        const f32x2 w2 = {w, w};
#pragma unroll
        for (int h = 0; h < 2; ++h) {
            const f32x2 p0 = __builtin_amdgcn_cvt_scalef32_pk_f32_fp4(uv[e][2 + h], 1.0f, 0), p1 = __builtin_amdgcn_cvt_scalef32_pk_f32_fp4(uv[e][2 + h], 1.0f, 1);
            const f32x2 p2 = __builtin_amdgcn_cvt_scalef32_pk_f32_fp4(uv[e][2 + h], 1.0f, 2), p3 = __builtin_amdgcn_cvt_scalef32_pk_f32_fp4(uv[e][2 + h], 1.0f, 3);
            f32x2 a0 = {acc[2 * h][0], acc[2 * h][1]}, a1 = {acc[2 * h][2], acc[2 * h][3]}, a2 = {acc[2 * h + 1][0], acc[2 * h + 1][1]}, a3 = {acc[2 * h + 1][2], acc[2 * h + 1][3]};
            a0 += w2 * p0; a1 += w2 * p1; a2 += w2 * p2; a3 += w2 * p3;
            acc[2 * h] = (f32x4){a0.x, a0.y, a1.x, a1.y}; acc[2 * h + 1] = (f32x4){a2.x, a2.y, a3.x, a3.y};
        }
    }
}
__device__ __forceinline__ void peer_retrieve_chunk(const unsigned short* SC, LAS unsigned* tabE, LAS float* tabG, int g, int lane) {
    const int row = lane >> 4, j = lane & 15;
    {
        const u32x4 raw = *(const u32x4*)(SC + g * 512 + lane * 8);
        unsigned k[8];
#pragma unroll
        for (int e = 0; e < 4; ++e) {
            const unsigned w = raw[e];
            k[2 * e] = (f16_order(w & 0xffffu) << 16) | (unsigned)(127 - (8 * j + 2 * e));
            k[2 * e + 1] = (f16_order(w >> 16) << 16) | (unsigned)(127 - (8 * j + 2 * e + 1));
        }
        cswap_desc(k[0], k[1]); cswap_desc(k[2], k[3]); cswap_desc(k[4], k[5]); cswap_desc(k[6], k[7]);
        cswap_desc(k[0], k[2]); cswap_desc(k[1], k[3]); cswap_desc(k[4], k[6]); cswap_desc(k[5], k[7]);
        cswap_desc(k[1], k[2]); cswap_desc(k[5], k[6]); cswap_desc(k[0], k[4]); cswap_desc(k[3], k[7]);
        cswap_desc(k[1], k[5]); cswap_desc(k[2], k[6]);
        cswap_desc(k[1], k[4]); cswap_desc(k[3], k[6]);
        cswap_desc(k[2], k[4]); cswap_desc(k[3], k[5]);
        cswap_desc(k[3], k[4]);
        unsigned mine = 0u;
#pragma unroll
        for (int it = 0; it < 16; ++it) {
            const unsigned w = row16_maxu(k[0]);
            if (k[0] == w) { k[0] = k[1]; k[1] = k[2]; k[2] = k[3]; k[3] = k[4]; k[4] = k[5]; k[5] = k[6]; k[6] = k[7]; k[7] = 0u; }
            mine = (j == it) ? w : mine;
        }
        const int hl = row >> 1, c = row & 1;
        static constexpr unsigned PTAB[32] = {0x31000u, 0x33020u, 0x35040u, 0x37060u, 0x39080u, 0x3b0a0u, 0x3d0c0u, 0x3f0e0u, 0x31101u, 0x33121u, 0x35141u, 0x37161u, 0x31202u, 0x33222u, 0x20042u, 0x31303u, 0x33323u, 0x31404u, 0x20024u, 0x31505u, 0x31606u, 0x31707u, 0x30908u, 0x30b0au, 0x30d0cu, 0x30f0eu, 0x00000u, 0x00000u, 0x00000u, 0x00000u, 0x00000u, 0x00000u};
        const unsigned te = PTAB[(row & 1) * 16 + j];
        const int a0 = te & 15, b0 = (te >> 4) & 15, a1 = (te >> 8) & 15, b1 = (te >> 12) & 15;
        const int base1 = (2 * hl) * 16, base2 = (2 * hl + 1) * 16;
        const unsigned k1a = (unsigned)__shfl((int)mine, base1 + a0), k2a = (unsigned)__shfl((int)mine, base2 + b0);
        const unsigned k1b = (unsigned)__shfl((int)mine, base1 + a1), k2b = (unsigned)__shfl((int)mine, base2 + b1);
        const float s0 = f16_unorder(k1a >> 16) + f16_unorder(k2a >> 16), s1 = f16_unorder(k1b >> 16) + f16_unorder(k2b >> 16);
        unsigned ck0 = ((te >> 17) & 1u) ? ((f32_order(s0) & 0xffffff00u) | (unsigned)(255 - (a0 * 16 + b0))) : 0u;
        unsigned ck1 = ((te >> 16) & 1u) ? ((f32_order(s1) & 0xffffff00u) | (unsigned)(255 - (a1 * 16 + b1))) : 0u;
        unsigned mine2 = 0u;
#pragma unroll
        for (int it = 0; it < 16; ++it) {
            unsigned w = row16_maxu(ck0);
            const unsigned w2 = swz16u(w); w = w > w2 ? w : w2;
            if (ck0 == w) { ck0 = ck1; ck1 = 0u; }
            mine2 = (j == it) ? w : mine2;
        }
        const int flat = 255 - (int)(mine2 & 0xffu), a = flat >> 4, bb = flat & 15;
        const unsigned ka = (unsigned)__shfl((int)mine, (2 * hl) * 16 + a), kb = (unsigned)__shfl((int)mine, (2 * hl + 1) * 16 + bb);
        const float sc = f16_unorder(ka >> 16) + f16_unorder(kb >> 16);
        const int i1 = 127 - (int)(ka & 0xffffu), i2 = 127 - (int)(kb & 0xffffu);
        const float smax = __shfl(sc, (lane & 48));
        const float ex = __expf(sc - smax);
        const float den = row16_sum(ex);
        if (c == 0) { const int slot = (2 * g + hl) * 16 + j; tabE[slot] = (unsigned)(i1 * 128 + i2) << 10; tabG[slot] = ex * __builtin_amdgcn_rcpf(den); }
    }
}
__device__ __forceinline__ void peer_phase(const Params& P, LAS unsigned char* lds, int gw, int NGW, int wave, int lane, bool alt) {
    unsigned char* ws = P.ws;
    LAS unsigned* tabs = (LAS unsigned*)(lds + wave * 16384);
    const int ntok = (NT - gw + NGW - 1) / NGW;
#if ENABLE_PEER
#pragma nounroll
    for (int g = 0; g < 4; ++g) peer_retrieve_chunk((const unsigned short*)(ws + WS_SC) + (size_t)gw * 2048, tabs, (LAS float*)(tabs + 128), g, lane);
    const unsigned char* UVb = (const unsigned char*)(ws + WS_UT);
    const float* TSC = (const float*)(ws + WS_TSC);
    const int myslot = (lane >> 2) & 15;
#endif
#pragma nounroll
    for (int k0 = 0; k0 < (ntok < 16 ? ntok : 16) * (PROBE_P7 == 2 ? 2 : 1); ++k0) {
        const int k = k0 & 15;
        const bool dummy = alt;
        const int t = gw + k * NGW;
        float* hrow = P.out + (size_t)t * DM;
        f32x4 acc[4];
#pragma unroll
        for (int i = 0; i < 4; ++i) acc[i] = (f32x4){0.f, 0.f, 0.f, 0.f};
        float hres[16];
        { const bf16_t* HBr = (const bf16_t*)(ws + WS_HG) + (size_t)t * DM; const u32x4 ca = *(const u32x4*)(HBr + lane * 16), cb = *(const u32x4*)(HBr + lane * 16 + 8);
#pragma unroll
          for (int i = 0; i < 4; ++i) { hres[2 * i] = bf_lo(ca[i]); hres[2 * i + 1] = bf_hi(ca[i]); hres[8 + 2 * i] = bf_lo(cb[i]); hres[8 + 2 * i + 1] = bf_hi(cb[i]); } }
#if ENABLE_PEER
        const LAS unsigned* tabE = tabs + k * 256; const LAS float* tabG = (const LAS float*)(tabE + 128);
        const float rs = rsqrtf(((const float*)(ws + WS_SS))[t] * (1.0f / DM) + RMS_EPS);
        int cH[2], cL[2]; float chalf, rsc;
        {
            float am = 0.f;
#pragma unroll
            for (int i = 0; i < 16; ++i) am = fmaxf(am, fabsf(hres[i]));
            am = wave_max(am);
            const float s_c = am * (1.0f / 119.0f) + 1e-30f, inv_c = 1.0f / s_c;
            int csum = 0;
#pragma unroll
            for (int h2 = 0; h2 < 2; ++h2) {
                unsigned wh = 0u, wl = 0u;
#pragma unroll
                for (int i = 0; i < 8; ++i) {
                    const int C = (int)rintf(hres[8 * h2 + i] * inv_c);
                    const int H = (C + 8) >> 4, L = C - 16 * H;
                    wh |= ((unsigned)H & 15u) << (4 * i); wl |= ((unsigned)L & 15u) << (4 * i);
                    csum += C;
                }
                cH[h2] = (int)wh; cL[h2] = (int)wl;
            }
            chalf = 0.5f * wave_sum((float)csum);
            rsc = rs * s_c;
        }
#pragma nounroll
        for (int bt = 0; bt < 8; ++bt) {
            u32x4 uv[16]; float su, sv;
            peer_issue(uv, su, sv, UVb, TSC, tabE, bt, myslot, (unsigned)lane * 16u);
            if (!(bt & 1) && k0 + 1 < (ntok < 16 ? ntok : 16))
                peer_retrieve_chunk((const unsigned short*)(ws + WS_SC) + (size_t)(t + NGW) * 2048, tabs + (k + 1) * 256, (LAS float*)(tabs + (k + 1) * 256 + 128), bt >> 1, lane);
            const float hval = peer_dot(uv, su, sv, cH, cL, chalf, rsc, tabG, bt, myslot, lane);
            peer_vphase(uv, hval, acc);
        }
#endif
        const float* fn = P.in[23];
        f32x4 y[4];
#pragma unroll
        for (int i = 0; i < 4; ++i) y[i] = (f32x4){hres[4 * i], hres[4 * i + 1], hres[4 * i + 2], hres[4 * i + 3]} + acc[i];
        float s = 0.f;
#pragma unroll
        for (int i = 0; i < 4; ++i) s += (y[i][0] * y[i][0] + y[i][1] * y[i][1]) + (y[i][2] * y[i][2] + y[i][3] * y[i][3]);
        const float rsf = rsqrtf(wave_sum(s) * (1.0f / DM) + RMS_EPS);
        float* orow = dummy ? (float*)(ws + 96 * MiB) + (size_t)t * 512 - lane * 0 : hrow;
        if (!dummy || lane < 32) {
#pragma unroll
            for (int i = 0; i < 4; ++i) *(f32x4*)(orow + lane * 16 + 4 * i) = y[i] * rsf * *(const f32x4*)(fn + lane * 16 + 4 * i);
        }
    }
}

typedef __attribute__((address_space(1))) unsigned gu32;
#define XB_TMO      128
#define XB_XCNT(j)  (256  + 64 * (j))
#define XB_XSUB(j)  (1280 + 64 * (j))
#define XB_XGEN(j)  (2304 + 64 * (j))
#define XB_TOP      3328
#define XB_TOPGEN   3392
#define XCD_BAR_WORDS 3456
#define XB_SPIN_CAP (1u << 18)

__device__ __forceinline__ unsigned xb_ld(unsigned* p)              { return __hip_atomic_load(p, __ATOMIC_RELAXED, __HIP_MEMORY_SCOPE_AGENT); }
__device__ __forceinline__ unsigned xb_add(unsigned* p, unsigned v) { return __hip_atomic_fetch_add(p, v, __ATOMIC_RELAXED, __HIP_MEMORY_SCOPE_AGENT); }
__device__ __forceinline__ unsigned xb_xcc_id() { return (unsigned)__builtin_amdgcn_s_getreg((3 << 11) | 20) & 0xFu; }
#define XB_SPIN(cond, bar) do { unsigned _sp = 0; while (cond) { __builtin_amdgcn_s_sleep(1); \
    if ((++_sp & 255u) == 0u) { if (xb_ld(&(bar)[XB_TMO])) break; if (_sp > XB_SPIN_CAP) { atomicAdd(&(bar)[XB_TMO], 1u); break; } } } } while (0)

struct XcdBarrier {
    unsigned* bar; unsigned x;
    volatile LAS unsigned* st;
};

__device__ __forceinline__ XcdBarrier xcd_barrier_post(unsigned* bar, volatile LAS unsigned* st) {
    XcdBarrier b; b.bar = bar; b.x = xb_xcc_id(); b.st = st;
    if (threadIdx.x == 0) (void)xb_add(&bar[XB_XCNT(b.x)], 1u);
    return b;
}
__device__ __forceinline__ void xcd_barrier_complete(unsigned* bar, unsigned x, unsigned& nloc, unsigned& nx) {
    const unsigned G = gridDim.x * gridDim.y * gridDim.z;
    unsigned sum, cnt, mine, sp = 0u;
    for (;;) {
        sum = 0u; cnt = 0u; mine = 0u;
#pragma unroll
        for (unsigned j = 0; j < 16; ++j) { const unsigned c = xb_ld(&bar[XB_XCNT(j)]); sum += c; cnt += (c > 0u) ? 1u : 0u; mine = (j == x) ? c : mine; }
        if (sum == G) break;
        __builtin_amdgcn_s_sleep(1);
        if ((++sp & 255u) == 0u) { if (xb_ld(&bar[XB_TMO])) break; if (sp > XB_SPIN_CAP) { atomicAdd(&bar[XB_TMO], 1u); break; } }
    }
    nloc = mine > 0u ? mine : 1u; nx = cnt > 0u ? cnt : 1u;
}

__device__ __forceinline__ void xcd_barrier(const XcdBarrier& b) {
    asm volatile("s_waitcnt vmcnt(0)" ::: "memory");
    __syncthreads();
    if (threadIdx.x == 0) {
        unsigned* bar = b.bar;
        __builtin_amdgcn_s_waitcnt(0);
        unsigned nloc = b.st[0], nx = b.st[1];
        if (nloc == 0u) { xcd_barrier_complete(bar, b.x, nloc, nx); b.st[0] = nloc; b.st[1] = nx; }
        const unsigned old = xb_add(&bar[XB_XSUB(b.x)], 1u);
        const unsigned gen = old / nloc;
        if (old + 1u == (gen + 1u) * nloc) {
            __builtin_amdgcn_fence(__ATOMIC_RELEASE, "agent");
            asm volatile("s_waitcnt vmcnt(0)" ::: "memory");
            const unsigned og = xb_add(&bar[XB_TOP], 1u);
            const unsigned tg = og / nx;
            if (og + 1u == (tg + 1u) * nx) xb_add(&bar[XB_TOPGEN], 1u);
            else XB_SPIN(xb_ld(&bar[XB_TOPGEN]) == tg, bar);
            __builtin_amdgcn_fence(__ATOMIC_ACQUIRE, "agent");
            xb_add(&bar[XB_XGEN(b.x)], 1u);
            asm volatile("s_waitcnt vmcnt(0)" ::: "memory");
        } else {
            XB_SPIN(xb_ld(&bar[XB_XGEN(b.x)]) == gen, bar);
            __builtin_amdgcn_fence(__ATOMIC_ACQUIRE, "agent");
            asm volatile("s_waitcnt vmcnt(0)" ::: "memory");
        }
    }
    __syncthreads();
}

__global__ void __launch_bounds__(NWAVES * 64, 2) mega_fwd(Params P) {
    extern __shared__ __attribute__((aligned(16))) unsigned char lds_raw[];
    LAS unsigned char* lds = (LAS unsigned char*)lds_raw;
    const int tid = threadIdx.x, lane = tid & 63, wave = __builtin_amdgcn_readfirstlane(tid >> 6);
    const int G = gridDim.x, bx = blockIdx.x;
    const int vcu = (G % 8 == 0) ? (bx % 8) * (G / 8) + bx / 8 : bx;
    const int gw = vcu * NWAVES + wave, NGW = G * NWAVES;
    unsigned char* ws = P.ws;
    const int lo = P.ph_lo, hi = P.ph_hi;
#ifndef PH_MASK
#define PH_MASK 0xff
#endif
#define IN_PH(k) (((PH_MASK >> (k)) & 1) && lo <= (k) && (k) < hi)
    volatile LAS unsigned* bst = (volatile LAS unsigned*)(lds + LDS_BYTES - 64);
    if (tid < 2) bst[tid] = 0u;
    __syncthreads();
    XcdBarrier xbar = xcd_barrier_post((unsigned*)(ws + WS_BAR), bst);
#if USE_XCD_BARRIER
#define SEAM(k) do { if (IN_PH(k) && IN_PH((k) + 1)) { xcd_barrier(xbar); } } while (0)
    if (P.ph_lo < 0) cg::this_grid().sync();
#else
#define SEAM(k) do { if (IN_PH(k) && IN_PH((k) + 1)) { cg::this_grid().sync(); } } while (0)
#endif

    if (IN_PH(0)) { p0_prep(P, lds, gw, NGW, wave, lane, 0); xcd_barrier(xbar); p0_prep(P, lds, gw, NGW, wave, lane, 1); }
    SEAM(0);
    if (IN_PH(1)) {
        pg8::Gemm g{(const bf16_t*)(ws + WS_A), (const bf16_t*)(ws + WS_WIN_T), NT, NPAD, DM / 2};
        pg8::StaticOrder S; S.init(NT, NPAD, G, bx);
        EpiInProj E{(bf16_t*)(ws + WS_ZA), (bf16_t*)(ws + WS_GM), (float*)(ws + WS_GN), (const float*)(ws + WS_ROPE), P.alt, (const float*)(ws + WS_ASC), (const float*)(ws + WS_WSC)};
        pg8::gemm_phase<EpiInProj, pg8::StaticOrder, true, true, true>(lds, g, S, E);
    }
    SEAM(1);
    if (IN_PH(2)) {
        for (int w = vcu; w < 256; w += G) compress_tasks(P, lds, w, wave, lane);
        for (int w0 = vcu; w0 < 256 * (1 + ((REPEAT_PH >> 2) & 1)); w0 += G) {
            const int w = w0 & 255;
            const int bh = w >> 3, s = w & 7;
#pragma nounroll
            for (int u = 0; u < 2; ++u) da_unit(P, lds, bh >> 2, bh & 3, u == 0 ? 15 - s : s, tid, lane, wave);
        }
    }
    SEAM(2);
    if (IN_PH(3)) {
#if ENABLE_NSA
        for (int w0 = vcu; w0 < 256 * (1 + ((REPEAT_PH >> 3) & 1)); w0 += G) {
            const int w = w0 & 255;
            const int bg = w >> 4, s = w & 15;
#pragma nounroll
            for (int u = 0; u < 4; ++u) nsa_unit(P, lds, bg >> 1, bg & 1, u == 0 ? 63 - s : (u == 1 ? 47 - s : (u == 2 ? 16 + s : s)), tid, lane, wave);
        }
#else
        { u32x4* z = (u32x4*)(ws + WS_YN); const size_t n16 = (size_t)NT * 512 * 2 / 16;
          for (size_t i = (size_t)gw * 64 + lane; i < n16; i += (size_t)NGW * 64) z[i] = (u32x4){0u, 0u, 0u, 0u}; }
#endif
    }
    SEAM(3);
    if (IN_PH(4)) {
        {
            pg8::Gemm g{(const bf16_t*)(ws + WS_YDA), (const bf16_t*)(ws + WS_PDA_T), NT, DM, 512};
            pg8::StaticOrder S; S.init(NT, DM, G, bx);
            EpiGate<0> E{(const bf16_t*)(ws + WS_GM), (bf16_t*)(ws + WS_TMP), (bf16_t*)(ws + WS_TMP)};
            pg8::gemm_phase<EpiGate<0>, pg8::StaticOrder, true, true>(lds, g, S, E);
        }
        asm volatile("s_waitcnt vmcnt(0)" ::: "memory"); __syncthreads();
        {
            pg8::Gemm g{(const bf16_t*)(ws + WS_YN), (const bf16_t*)(ws + WS_PNSA_T), NT, DM, 512};
            pg8::StaticOrder S; S.init(NT, DM, G, bx);
            EpiGate<1> E{(const bf16_t*)(ws + WS_GM), (bf16_t*)(ws + WS_TMP), (bf16_t*)(ws + WS_MERGED)};
            pg8::gemm_phase<EpiGate<1>, pg8::StaticOrder, true, true>(lds, g, S, E);
        }
    }
    SEAM(4);
    if (IN_PH(5)) {
        pg8::Gemm g{(const bf16_t*)(ws + WS_MERGED), (const bf16_t*)(ws + WS_WO_T), NT, DM, DM};
        pg8::StaticOrder S; S.init(NT, DM, G, bx);
        EpiWo E{P.in[0], (bf16_t*)(ws + WS_HG), (float*)(ws + (P.alt ? WS_SS + 512 * 1024 : WS_SS))};
        pg8::gemm_phase<EpiWo, pg8::StaticOrder, true, true>(lds, g, S, E);
    }
    SEAM(5);
    if (IN_PH(6)) {
#if ENABLE_PEER
        pg8::Gemm g{(const bf16_t*)(ws + WS_HG), (const bf16_t*)(ws + WS_WP_T), NT, 2048, DM};
        TableOrder S; S.init(NT, 2048, G, bx); S.P = &P; S.gw = gw; S.calls = 0;
        EpiScores E{(const float*)(ws + WS_SS), (unsigned short*)(ws + WS_SC)};
        pg8::gemm_phase<EpiScores, TableOrder, true, true>(lds, g, S, E);
        for (int c = S.calls; c < 4; ++c) convert_table_rows<4>(P, (gw * 4 + c) * 4, lane);
#endif
    }
    SEAM(6);
    if (IN_PH(7)) {
        peer_phase(P, lds, gw, NGW, wave, lane, P.alt != 0);
    }
#if UBENCH
    {
        unsigned x[8]; f32x2 a[8];
#pragma unroll
        for (int i = 0; i < 8; ++i) { x[i] = (unsigned)(tid * 2654435761u + i * 40503u); a[i] = (f32x2){(float)i, 1.0f}; }
#pragma nounroll
        for (int it = 0; it < 4096; ++it) {
#pragma unroll
            for (int i = 0; i < 8; ++i) {
#if UBENCH == 1
                const f32x2 p = __builtin_amdgcn_cvt_scalef32_pk_f32_fp4(x[i], 1.0f, 0), q = __builtin_amdgcn_cvt_scalef32_pk_f32_fp4(x[i], 1.0f, 1);
                x[i] = x[i] * 5u + __float_as_uint(p.x + q.y);
#elif UBENCH == 2
                a[i] = a[i] * (f32x2){1.0001f, 0.9999f} + (f32x2){0.5f, 0.25f}; a[i] = a[i] * (f32x2){0.9999f, 1.0001f} + (f32x2){0.25f, 0.5f};
#elif UBENCH == 3
                const f32x2 p = __builtin_amdgcn_cvt_pk_f32_fp8((int)x[i], false), q = __builtin_amdgcn_cvt_pk_f32_fp8((int)x[i], true);
                x[i] = x[i] * 5u + __float_as_uint(p.x + q.y);
#elif UBENCH == 5
                x[i] = x[i] * 5u + __float_as_uint(__builtin_amdgcn_exp2f(__uint_as_float(x[i] & 0xbfffffffu)) + __builtin_amdgcn_exp2f(__uint_as_float((x[i] >> 1) & 0xbfffffffu)));
#elif UBENCH == 6
                x[i] = (unsigned)__builtin_amdgcn_sdot8((int)x[i], (int)(x[i] >> 3), (int)x[i], false); x[i] = (unsigned)__builtin_amdgcn_sdot8((int)x[i], 0x12345678, (int)x[i], false);
#elif UBENCH == 4
                x[i] = x[i] * 5u + __float_as_uint(__uint_as_float(x[i]) + 1.0f);
#endif
            }
        }
        unsigned r = 0; float fs = 0.f;
#pragma unroll
        for (int i = 0; i < 8; ++i) { r ^= x[i]; fs += a[i].x + a[i].y; }
        if ((r ^ __float_as_uint(fs)) == 0x12345678u) ((unsigned*)(ws + WS_MISC))[1000 + (tid & 7)] = r;
    }
#endif
#undef IN_PH
#undef SEAM
}

extern "C" void kernel_launch(void* const* d_in, const int* in_sizes, int n_in, void* d_out, int out_size, void* d_ws, size_t ws_size, hipStream_t stream) {
    static int grid = 0;
    if (grid == 0) {
        if (n_in != 24 || in_sizes[0] != NT * DM || out_size != NT * DM || ws_size < WS_END) {
            fprintf(stderr, "kernel_launch: unexpected shapes (n_in %d, in0 %d, out %d, ws %zu); nothing launched\n", n_in, n_in > 0 ? in_sizes[0] : -1, out_size, ws_size); grid = -1; return; }
        int dev = 0, cus = 0, per_cu = 0;
        hipGetDevice(&dev); hipDeviceGetAttribute(&cus, hipDeviceAttributeMultiprocessorCount, dev);
        if (hipFuncSetAttribute((const void*)mega_fwd, hipFuncAttributeMaxDynamicSharedMemorySize, LDS_BYTES) != hipSuccess) { fprintf(stderr, "kernel_launch: hipFuncSetAttribute failed\n"); grid = -1; return; }
        if (hipOccupancyMaxActiveBlocksPerMultiprocessor(&per_cu, (const void*)mega_fwd, NWAVES * 64, LDS_BYTES) != hipSuccess || per_cu < 1) { fprintf(stderr, "kernel_launch: occupancy query says %d\n", per_cu); per_cu = 1; }
        (void)hipGetLastError();
        grid = cus;
        if (grid > 256) grid = 256;
    }
    if (grid < 0) return;
    if (hipMemsetAsync((char*)d_ws + WS_BAR, 0, 131072, stream) != hipSuccess) { fprintf(stderr, "kernel_launch: hipMemsetAsync failed\n"); return; }
    Params p{};
    for (int i = 0; i < 24; ++i) p.in[i] = (const float*)d_in[i];
    p.out = (float*)d_out; p.ws = (unsigned char*)d_ws;
#if N_LAUNCH_MODE == 1
    p.ph_lo = 0; p.ph_hi = 8; p.alt = 0;
    void* args[] = {&p};
    hipError_t e = hipLaunchCooperativeKernel((const void*)mega_fwd, dim3(grid), dim3(NWAVES * 64), args, LDS_BYTES, stream);
    if (e != hipSuccess) fprintf(stderr, "kernel_launch: cooperative launch failed: %s (grid %d)\n", hipGetErrorString(e), grid);
#else
    for (int ph = 0; ph < 8; ++ph) {
        p.ph_lo = ph; p.ph_hi = ph + 1;
        for (int rep = 0; rep < ((ph == REPEAT_LAUNCH) ? 2 : 1); ++rep) {
            p.alt = (ph == REPEAT_LAUNCH && rep == 0) ? 1 : 0;
            hipLaunchKernelGGL(mega_fwd, dim3(grid), dim3(NWAVES * 64), LDS_BYTES, stream, p);
        }
    }
#endif
}
```

```cpp
#include <hip/hip_runtime.h>
#include <hip/hip_cooperative_groups.h>
#include <hip/hip_bf16.h>
#include <cstdio>
#include <cstdint>
#include <cmath>
namespace cg = cooperative_groups;
namespace pg8 {
#define PG8_LAS __attribute__((address_space(3)))
typedef unsigned short bf16_t;
typedef short bf16x8 __attribute__((ext_vector_type(8)));
typedef float f32x4 __attribute__((ext_vector_type(4)));
typedef unsigned u32x4 __attribute__((ext_vector_type(4)));
constexpr int BM = 256, BK = 64, HALF = 128, HTB = HALF * BK * 2  , STAGE_BYTES = 8 * HTB, NXCD = 8, WGM = 8;

__host__ __device__ __forceinline__ int lds_byte(int r, int c) { const int st = (r >> 4) * 2 + (c >> 5), rr = r & 15, cc = c & 31, ob = rr * 64 + cc * 2; return st * 1024 + (ob ^ (((ob >> 9) & 1) << 5)); }
__host__ __device__ __forceinline__ void stage_rc(int b, int& R, int& C) { const int st = b / 1024, sb = b % 1024, swz = sb ^ (((sb >> 9) & 1) << 5); R = (st >> 1) * 16 + swz / 64; C = (st & 1) * 32 + (swz % 64) / 2; }
__host__ __device__ __forceinline__ int perm32(int rho) { const int n = rho >> 4, i = rho & 15; return 8 * (i >> 2) + 4 * n + (i & 3); }

struct Unit { int pm, pn; };
struct Gemm { const bf16_t* A; const bf16_t* Bt; int M, N, K; };

struct StaticOrder {
    int nM, nN, nwg, G, c;
    __host__ __device__ void init(int M, int N, int G_, int c_) { nM = M / BM; nN = N / BM; nwg = nM * nN; G = G_; c = c_; }
    __host__ __device__ bool next(int i, Unit& u) const {
        const long L = (long)i * G + c; if (L >= nwg) return false;
        int wgid = (int)L; { const int q = nwg / NXCD, r = nwg % NXCD, xcd = wgid % NXCD, off = wgid / NXCD; wgid = (xcd < r ? xcd * (q + 1) : r * (q + 1) + (xcd - r) * q) + off; }
        const int nig = WGM * nN, gid = wgid / nig, fm = gid * WGM, gsz = (nM - fm) < WGM ? (nM - fm) : WGM;
        u.pm = fm + ((wgid % nig) % gsz); u.pn = (wgid % nig) / gsz; return true;
    }
    __device__ __forceinline__ void a_ready(const Unit&) const {}
    __device__ __forceinline__ void done(const Unit&) const {}
};

__device__ __forceinline__ unsigned cvt_pk_bf16(float lo, float hi) { unsigned r; asm volatile("v_cvt_pk_bf16_f32 %0, %1, %2" : "=v"(r) : "v"(lo), "v"(hi)); return r; }
typedef float f32x2 __attribute__((ext_vector_type(2)));
typedef int i32x4 __attribute__((ext_vector_type(4)));
template <class Epi, class Sched, bool ALIGN_EPI = false, bool SP2 = false, bool I8 = false>
__device__ __forceinline__ void gemm_phase(PG8_LAS unsigned char* lds, const Gemm g, const Sched& S, const Epi& E) {
    const int tid = threadIdx.x, wid = __builtin_amdgcn_readfirstlane(tid >> 6), lane = tid & 63, wr = wid >> 2, wc = wid & 3, fr = lane & 15, fq = lane >> 4;
    const int K = g.K, nt = K / BK;
    unsigned voffA[2], voffB[2];
#pragma unroll
    for (int i = 0; i < 2; ++i) { int R, C; stage_rc(tid * 16 + i * 8192, R, C); const int Rb = Epi::PERM ? ((R & ~31) + perm32(R & 31)) : R;
        voffA[i] = (unsigned)(R * K + C) * 2u; voffB[i] = (unsigned)(Rb * K + C) * 2u; }
    const size_t kstep = (size_t)(BK * 2);
    const size_t hstep = (size_t)HALF * K * 2;
    const size_t tstep = 2 * hstep;
    const unsigned ldsw = (unsigned)wid * 1024u;
    const int aoff = lds_byte(wr * 64 + fr, fq * 8), boff = lds_byte(wc * 32 + fr, fq * 8);
#define PG8_SA(b, h) (((b) * 2 + (h)) * HTB)
#define PG8_SB(b, h) ((4 + (b) * 2 + (h)) * HTB)
#define PG8_STAGE(bufoff, gbase, voff) do { _Pragma("unroll") for (int _i = 0; _i < 2; ++_i) \
        __builtin_amdgcn_global_load_lds((const unsigned*)((const char*)(gbase) + (voff)[_i]), (PG8_LAS unsigned*)(lds + (bufoff) + ldsw + _i * 8192), 16, 0, 0); } while (0)
#define PG8_LDA(dst, b, h) do { _Pragma("unroll") for (int m = 0; m < 4; ++m) _Pragma("unroll") for (int k = 0; k < 2; ++k) dst[m][k] = *(const PG8_LAS bf16x8*)(lds + PG8_SA(b, h) + aoff + m * 2048 + k * 1024); } while (0)
#define PG8_LDB(dst, b, h) do { _Pragma("unroll") for (int n = 0; n < 2; ++n) _Pragma("unroll") for (int k = 0; k < 2; ++k) dst[n][k] = *(const PG8_LAS bf16x8*)(lds + PG8_SB(b, h) + boff + n * 2048 + k * 1024); } while (0)
#define PG8_MMA(ai, bj, At, Bt) do { __builtin_amdgcn_s_setprio(1); _Pragma("unroll") for (int m = 0; m < 4; ++m) _Pragma("unroll") for (int n = 0; n < 2; ++n) _Pragma("unroll") for (int k = 0; k < 2; ++k) { \
        if constexpr (I8) acc[ai][bj][m][n] = __builtin_bit_cast(f32x4, __builtin_amdgcn_mfma_i32_16x16x64_i8(__builtin_bit_cast(i32x4, Bt[n][k]), __builtin_bit_cast(i32x4, At[m][k]), __builtin_bit_cast(i32x4, acc[ai][bj][m][n]), 0, 0, 0)); \
        else acc[ai][bj][m][n] = __builtin_amdgcn_mfma_f32_16x16x32_bf16(Bt[n][k], At[m][k], acc[ai][bj][m][n], 0, 0, 0); } __builtin_amdgcn_s_setprio(0); } while (0)
#define PG8_WAIT_V(n) asm volatile("s_waitcnt vmcnt(" #n ")" ::: "memory")
#define PG8_WAIT_L(n) asm volatile("s_waitcnt lgkmcnt(" #n ")" ::: "memory")
#define PG8_BAR __builtin_amdgcn_s_barrier()
#define PG8_SCHED __builtin_amdgcn_sched_barrier(0)
    Unit cur, nxt; int ui = 0;
    if (!S.next(0, cur)) return;
    f32x4 acc[2][2][4][2];
#pragma unroll
    for (int a = 0; a < 2; ++a)
#pragma unroll
        for (int b = 0; b < 2; ++b)
#pragma unroll
            for (int m = 0; m < 4; ++m)
#pragma unroll
                for (int n = 0; n < 2; ++n) acc[a][b][m][n] = (f32x4){0.f, 0.f, 0.f, 0.f};
    bf16x8 At[4][2], B0[2][2], B1[2][2];
    const char* cA = (const char*)g.A + (size_t)cur.pm * tstep; const char* cB = (const char*)g.Bt + (size_t)cur.pn * tstep;
    S.a_ready(cur);
    if constexpr (SP2) {
        PG8_STAGE(PG8_SB(0, 0), cB, voffB); PG8_STAGE(PG8_SB(0, 1), cB + hstep, voffB); PG8_STAGE(PG8_SA(0, 0), cA, voffA); PG8_STAGE(PG8_SA(0, 1), cA + hstep, voffA);
        if (wr == 1) PG8_BAR;
        PG8_WAIT_V(2); PG8_BAR;
        PG8_STAGE(PG8_SB(1, 0), cB + kstep, voffB); PG8_STAGE(PG8_SA(1, 0), cA + kstep, voffA); PG8_STAGE(PG8_SB(1, 1), cB + hstep + kstep, voffB);
        PG8_WAIT_V(6); PG8_BAR;
    } else {
        PG8_STAGE(PG8_SB(0, 0), cB, voffB); PG8_STAGE(PG8_SA(0, 0), cA, voffA); PG8_STAGE(PG8_SB(0, 1), cB + hstep, voffB); PG8_STAGE(PG8_SA(0, 1), cA + hstep, voffA);
        if (wr == 1) PG8_BAR;
        PG8_WAIT_V(4); PG8_BAR;
        PG8_STAGE(PG8_SB(1, 0), cB + kstep, voffB); PG8_STAGE(PG8_SA(1, 0), cA + kstep, voffA); PG8_STAGE(PG8_SB(1, 1), cB + hstep + kstep, voffB);
        PG8_WAIT_V(6); PG8_BAR;
    }
    for (;;) {
        const bool has_next = S.next(ui + 1, nxt);
        const char* nA = has_next ? (const char*)g.A + (size_t)nxt.pm * tstep : cA; const char* nB = has_next ? (const char*)g.Bt + (size_t)nxt.pn * tstep : cB;
        for (int t = 0; t < nt; t += 2) {
            const bool last = (t == nt - 2);
            const char* a1 = cA + (size_t)(t + 1) * kstep;
            const char* a2 = last ? nA : cA + (size_t)(t + 2) * kstep; const char* b2 = last ? nB : cB + (size_t)(t + 2) * kstep;
            const char* a3 = a2 + kstep; const char* b3 = b2 + kstep;
            if (last && has_next) S.a_ready(nxt);
            if constexpr (SP2) {
            PG8_LDB(B0, 0, 0); PG8_LDB(B1, 0, 1); PG8_SCHED; PG8_LDA(At, 0, 0); PG8_STAGE(PG8_SA(1, 1), a1 + hstep, voffA);
            PG8_WAIT_V(8); PG8_WAIT_L(0); PG8_BAR; PG8_MMA(0, 0, At, B0); PG8_MMA(0, 1, At, B1); PG8_BAR; PG8_SCHED;
            PG8_LDA(At, 0, 1); PG8_STAGE(PG8_SB(0, 0), b2, voffB); PG8_STAGE(PG8_SB(0, 1), b2 + hstep, voffB); PG8_STAGE(PG8_SA(0, 0), a2, voffA);
            PG8_WAIT_V(8); PG8_WAIT_L(0); PG8_BAR; PG8_MMA(1, 0, At, B0); PG8_MMA(1, 1, At, B1); PG8_BAR; PG8_SCHED;
            PG8_LDB(B0, 1, 0); PG8_LDB(B1, 1, 1); PG8_SCHED; PG8_LDA(At, 1, 0); PG8_STAGE(PG8_SA(0, 1), a2 + hstep, voffA);
            PG8_WAIT_V(8); PG8_WAIT_L(0); PG8_BAR; PG8_MMA(0, 0, At, B0); PG8_MMA(0, 1, At, B1); PG8_BAR; PG8_SCHED;
            PG8_LDA(At, 1, 1); PG8_STAGE(PG8_SB(1, 0), b3, voffB); PG8_STAGE(PG8_SB(1, 1), b3 + hstep, voffB); PG8_STAGE(PG8_SA(1, 0), a3, voffA);
            PG8_WAIT_V(8); PG8_WAIT_L(0); PG8_BAR; PG8_MMA(1, 0, At, B0); PG8_MMA(1, 1, At, B1); PG8_BAR; PG8_SCHED;
            } else {
            PG8_LDB(B0, 0, 0); PG8_SCHED; PG8_LDA(At, 0, 0); PG8_STAGE(PG8_SA(1, 1), a1 + hstep, voffA);
            PG8_WAIT_L(8); PG8_BAR; PG8_WAIT_L(0); PG8_MMA(0, 0, At, B0); PG8_BAR; PG8_SCHED;
            PG8_LDB(B1, 0, 1); PG8_STAGE(PG8_SB(0, 0), b2, voffB);
            PG8_BAR; PG8_WAIT_L(0); PG8_MMA(0, 1, At, B1); PG8_BAR;
            PG8_LDA(At, 0, 1); PG8_STAGE(PG8_SA(0, 0), a2, voffA);
            PG8_BAR; PG8_WAIT_L(0); PG8_MMA(1, 0, At, B0); PG8_BAR; PG8_SCHED;
            PG8_STAGE(PG8_SB(0, 1), b2 + hstep, voffB);
            PG8_WAIT_V(6); PG8_BAR; PG8_MMA(1, 1, At, B1); PG8_BAR;
            PG8_LDB(B0, 1, 0); PG8_SCHED; PG8_LDA(At, 1, 0); PG8_STAGE(PG8_SA(0, 1), a2 + hstep, voffA);
            PG8_WAIT_L(8); PG8_BAR; PG8_WAIT_L(0); PG8_MMA(0, 0, At, B0); PG8_BAR; PG8_SCHED;
            PG8_LDB(B1, 1, 1); PG8_STAGE(PG8_SB(1, 0), b3, voffB);
            PG8_BAR; PG8_WAIT_L(0); PG8_MMA(0, 1, At, B1); PG8_BAR;
            PG8_LDA(At, 1, 1); PG8_STAGE(PG8_SA(1, 0), a3, voffA);
            PG8_BAR; PG8_WAIT_L(0); PG8_MMA(1, 0, At, B0); PG8_BAR; PG8_SCHED;
            PG8_STAGE(PG8_SB(1, 1), b3 + hstep, voffB);
            PG8_WAIT_V(6); PG8_BAR; PG8_MMA(1, 1, At, B1); PG8_BAR;
            }
        }
        if constexpr (ALIGN_EPI) { if (wr == 0) PG8_BAR; }
        if constexpr (!Epi::AFTER_DRAIN) { E(acc, cur, wr, wc, fr, fq); S.done(cur); }
        if (!has_next) break;
#pragma unroll
        for (int a = 0; a < 2; ++a)
#pragma unroll
            for (int b = 0; b < 2; ++b)
#pragma unroll
                for (int m = 0; m < 4; ++m)
#pragma unroll
                    for (int n = 0; n < 2; ++n) acc[a][b][m][n] = (f32x4){0.f, 0.f, 0.f, 0.f};
        cur = nxt; cA = nA; cB = nB; ++ui;
        if constexpr (ALIGN_EPI) { if (wr == 1) PG8_BAR; }
    }
    PG8_WAIT_V(0);
    if constexpr (!ALIGN_EPI) { if (wr == 0) PG8_BAR; }
    PG8_BAR;
    if constexpr (Epi::AFTER_DRAIN) { E.fused(acc, cur, wr, wc, fr, fq, lds, wid, lane); S.done(cur); }
#undef PG8_SA
#undef PG8_SB
#undef PG8_STAGE
#undef PG8_LDA
#undef PG8_LDB
#undef PG8_MMA
#undef PG8_WAIT_V
#undef PG8_WAIT_L
#undef PG8_BAR
#undef PG8_SCHED
}
}

#define LAS __attribute__((address_space(3)))
typedef unsigned short bf16_t;
typedef short bf16x8 __attribute__((ext_vector_type(8)));
typedef short s16x4 __attribute__((ext_vector_type(4)));
typedef float f32x4 __attribute__((ext_vector_type(4)));
typedef float f32x2 __attribute__((ext_vector_type(2)));
typedef float f32x16 __attribute__((ext_vector_type(16)));
typedef unsigned u32x4 __attribute__((ext_vector_type(4)));
typedef unsigned u32x2 __attribute__((ext_vector_type(2)));
typedef __bf16 bf16x2_t __attribute__((ext_vector_type(2)));
typedef _Float16 f16x2_t __attribute__((ext_vector_type(2)));

#ifndef ENABLE_NSA
#define ENABLE_NSA 1
#endif
#ifndef ENABLE_PEER
#define ENABLE_PEER 1
#endif
#ifndef PEER_SIMPLE_REDUCE
#define PEER_SIMPLE_REDUCE 0
#endif
#ifndef PEER_CHECK
#define PEER_CHECK 0
#endif
#ifndef PEER_MANUAL_DOT
#define PEER_MANUAL_DOT 1
#endif
#ifndef REPEAT_PH
#define REPEAT_PH 0
#endif
#ifndef USE_XCD_BARRIER
#define USE_XCD_BARRIER 1
#endif
#ifndef TS_PROBE
#define TS_PROBE -1
#endif
#ifndef PROBE_P7
#define PROBE_P7 0
#endif
#ifndef REPEAT_LAUNCH
#define REPEAT_LAUNCH -1
#endif
#ifndef MFMA_NIBSWAP
#define MFMA_NIBSWAP 0
#endif
#ifndef MFMA_DEBUG
#define MFMA_DEBUG 0
#endif
#ifndef ALT_VAL
#define ALT_VAL 1
#endif
#ifndef UBENCH
#define UBENCH 0
#endif
#ifndef N_LAUNCH_MODE
#define N_LAUNCH_MODE 1
#endif

constexpr int NB = 8, SEQ = 4096, DM = 1024, NT = NB * SEQ;
constexpr int IN_COLS = 4888, NPAD = 5120, ZP = 2816;
constexpr int NEXP = 16384;
constexpr float RMS_EPS = 1e-6f;
constexpr float C2 = 0.125f * 1.4426950408889634f;
constexpr float LAMBDA_INIT = 0.2f;
constexpr int ZC_QDA = 0, ZC_KDA = 512, ZC_VDA = 1024, ZC_QN = 1536, ZC_KC = 2048, ZC_VC = 2176, ZC_KS = 2304, ZC_VS = 2432, ZC_KW = 2560, ZC_VW = 2688;

constexpr size_t MiB = 1u << 20;
constexpr size_t WS_BAR = 0;
constexpr size_t WS_ROPE = 1 * MiB;
constexpr size_t WS_MISC = 2 * MiB;
constexpr size_t WS_SS = 3 * MiB;
constexpr size_t WS_WIN_T = 8 * MiB;
constexpr size_t WS_PDA_T = 18 * MiB;
constexpr size_t WS_PNSA_T = 19 * MiB;
constexpr size_t WS_WO_T = 20 * MiB;
constexpr size_t WS_WP_T = 22 * MiB;
constexpr size_t WS_CW1_T = 26 * MiB;
constexpr size_t WS_CW2_T = 26 * MiB + 512 * 1024;
constexpr size_t WS_KC = 27 * MiB;
constexpr size_t WS_GN = 28 * MiB;
constexpr size_t WS_UT = 32 * MiB;
constexpr size_t WS_CMAX = 64 * 1024;
constexpr size_t WS_WSC = 5 * MiB;
constexpr size_t WS_ASC = 6 * MiB;
constexpr size_t WS_TSC = 4 * MiB;
constexpr size_t WS_A = 96 * MiB;
constexpr size_t WS_YDA = 96 * MiB, WS_YN = 128 * MiB;
constexpr size_t WS_GM = 160 * MiB;
constexpr size_t WS_SC = 160 * MiB;
constexpr size_t WS_ZA = 288 * MiB;
constexpr size_t WS_TMP = 288 * MiB, WS_MERGED = 352 * MiB, WS_HG = 416 * MiB;
constexpr size_t WS_END = 480 * MiB;

constexpr int LDS_BYTES = 147456;
constexpr int NWAVES = 8;

__device__ __forceinline__ unsigned pk_bf16(float lo, float hi) { f32x2 v = {lo, hi}; bf16x2_t b = __builtin_convertvector(v, bf16x2_t); return __builtin_bit_cast(unsigned, b); }
__device__ __forceinline__ unsigned pk_f16(float lo, float hi) { f32x2 v = {lo, hi}; f16x2_t b = __builtin_convertvector(v, f16x2_t); return __builtin_bit_cast(unsigned, b); }
__device__ __forceinline__ float bf_lo(unsigned u) { return __builtin_bit_cast(float, u << 16); }
__device__ __forceinline__ float bf_hi(unsigned u) { return __builtin_bit_cast(float, u & 0xffff0000u); }

__device__ __forceinline__ float sigmoidf_(float x) { return __builtin_amdgcn_rcpf(1.0f + __expf(-x)); }
__device__ __forceinline__ float gelu_erf(float v) { return 0.5f * v * (1.0f + erff(v * 0.70710678118654752f)); }
__device__ __forceinline__ float gelu_poly(float v) {
    const float av = fabsf(v), t = __builtin_amdgcn_rcpf(av * 0.2316418882f + 1.0f);
    float q = t * 0.5307027145f + (-0.7265760135f); q = q * t + 0.7107068705f; q = q * t + (-0.142248368f); q = q * t + 0.127414796f; q = q * t;
    const float e = __builtin_amdgcn_exp2f((v * v) * (-0.72134752044f));
    const float m = v * (q * e), r = v - m;
    return v < 0.f ? m : r;
}
__device__ __forceinline__ float swap32_other(float x) {
    auto rr = __builtin_amdgcn_permlane32_swap(__float_as_uint(x), __float_as_uint(x), false, false);
    return (threadIdx.x & 32) ? __uint_as_float(rr[0]) : __uint_as_float(rr[1]);
}
template <int CTRL> __device__ __forceinline__ float dppf(float x) { return __int_as_float(__builtin_amdgcn_mov_dpp(__float_as_int(x), CTRL, 0xF, 0xF, true)); }
template <int CTRL> __device__ __forceinline__ unsigned dppu(unsigned x) { return (unsigned)__builtin_amdgcn_mov_dpp((int)x, CTRL, 0xF, 0xF, true); }
constexpr int DPP_XOR1 = 0xB1, DPP_XOR2 = 0x4E, DPP_HMIRROR = 0x141, DPP_MIRROR = 0x140, DPP_ROR8 = 0x128;
__device__ __forceinline__ float swz16f(float x) { return __int_as_float(__builtin_amdgcn_ds_swizzle(__float_as_int(x), 0x401F)); }
__device__ __forceinline__ unsigned swz16u(unsigned x) { return (unsigned)__builtin_amdgcn_ds_swizzle((int)x, 0x401F); }
__device__ __forceinline__ float row16_sum(float v) { v += dppf<DPP_XOR1>(v); v += dppf<DPP_XOR2>(v); v += dppf<DPP_HMIRROR>(v); v += dppf<DPP_MIRROR>(v); return v; }
__device__ __forceinline__ float wave_max(float v) { v = fmaxf(v, dppf<DPP_XOR1>(v)); v = fmaxf(v, dppf<DPP_XOR2>(v)); v = fmaxf(v, dppf<DPP_HMIRROR>(v)); v = fmaxf(v, dppf<DPP_MIRROR>(v)); v = fmaxf(v, swz16f(v)); v = fmaxf(v, swap32_other(v)); return v; }
__device__ __forceinline__ float wave_sum(float v) { v = row16_sum(v); v += swz16f(v); v += swap32_other(v); return v; }
__device__ __forceinline__ unsigned row16_maxu(unsigned v) { unsigned t;
    t = dppu<DPP_XOR1>(v); v = v > t ? v : t; t = dppu<DPP_XOR2>(v); v = v > t ? v : t; t = dppu<DPP_HMIRROR>(v); v = v > t ? v : t; t = dppu<DPP_MIRROR>(v); v = v > t ? v : t; return v; }

struct Params {
    const float* in[24]; float* out; unsigned char* ws; int ph_lo, ph_hi, alt, pad;
};

struct EpiInProj {
    static constexpr bool PERM = true, AFTER_DRAIN = false;
    bf16_t* ZA; bf16_t* GM; float* GN; const float* rope; int plain; const float* asc; const float* wsc;
    __device__ __forceinline__ void operator()(const f32x4 (&acc)[2][2][4][2], const pg8::Unit& u, int wr, int wc, int fr, int fq) const {
        const int pn = u.pn;
        const bool is_rope_lane = ((wc & 1) == 0) && (fq < 2);
        const float sgn = (fq == 0) ? -1.f : 1.f;
#pragma unroll
        for (int ai = 0; ai < 2; ++ai) {
            f32x4 rpv[4][4];
#pragma unroll
            for (int m = 0; m < 4; ++m) {
                if ((m & 1) == 0 && pn <= 10 && is_rope_lane && !plain) {
#pragma unroll
                    for (int mm = m; mm < m + 2; ++mm) {
                        const int pos = (u.pm * 256 + ai * 128 + wr * 64 + mm * 16 + fr) & (SEQ - 1);
                        const f32x4* rp = (const f32x4*)(rope + (size_t)pos * 16);
                        rpv[mm][0] = rp[0]; rpv[mm][1] = rp[1]; rpv[mm][2] = rp[2]; rpv[mm][3] = rp[3];
                    }
                }
                const int row = u.pm * 256 + ai * 128 + wr * 64 + m * 16 + fr;
                const float ra = asc[row];
#pragma unroll
                for (int bj = 0; bj < 2; ++bj) {
                    const int ct = bj * 128 + wc * 32 + fq * 8;
                    float v[8];
                    const f32x4 ws0 = *(const f32x4*)(wsc + pn * 256 + ct), ws1 = *(const f32x4*)(wsc + pn * 256 + ct + 4);
#pragma unroll
                    for (int i = 0; i < 4; ++i) { v[i] = (float)__float_as_int(acc[ai][bj][m][0][i]) * (ra * ws0[i]); v[4 + i] = (float)__float_as_int(acc[ai][bj][m][1][i]) * (ra * ws1[i]); }
                    if (pn <= 10) {
                        const bool rope_tile = (pn < 4) || (pn == 6) || (pn == 7) || (pn >= 8 && bj == 0);
                        if (rope_tile && !plain) {
                            float pv[8];
#pragma unroll
                            for (int i = 0; i < 8; ++i) pv[i] = swz16f(v[i]);
                            if (is_rope_lane) {
                                const f32x4 c0 = rpv[m][0], c1 = rpv[m][1], s0 = rpv[m][2], s1 = rpv[m][3];
#pragma unroll
                                for (int i = 0; i < 4; ++i) { v[i] = v[i] * c0[i] + sgn * pv[i] * s0[i]; v[4 + i] = v[4 + i] * c1[i] + sgn * pv[4 + i] * s1[i]; }
                            }
                        }
                        const float sc = (pn < 2 || pn == 6 || pn == 7) ? C2 : 1.0f;
                        u32x4 w; w.x = pk_bf16(v[0] * sc, v[1] * sc); w.y = pk_bf16(v[2] * sc, v[3] * sc); w.z = pk_bf16(v[4] * sc, v[5] * sc); w.w = pk_bf16(v[6] * sc, v[7] * sc);
                        *(u32x4*)(ZA + (size_t)row * ZP + pn * 256 + ct) = w;
                    } else if (pn <= 18) {
                        if (!plain) {
#pragma unroll
                        for (int i = 0; i < 8; ++i) v[i] = sigmoidf_(v[i]);
                        }
                        unsigned w0 = 0u, w1 = 0u;
#pragma unroll
                        for (int i = 0; i < 4; ++i) { w0 = __builtin_amdgcn_cvt_pk_u8_f32(v[i] * 255.0f, i, w0); w1 = __builtin_amdgcn_cvt_pk_u8_f32(v[4 + i] * 255.0f, i, w1); }
                        *(u32x2*)((unsigned char*)GM + (size_t)row * 2048 + (pn - 11) * 256 + ct) = (u32x2){w0, w1};
                    } else {
                        if (bj == 0 && wc == 0) {
                            f32x4 a = {sigmoidf_(v[0]), sigmoidf_(v[1]), sigmoidf_(v[2]), sigmoidf_(v[3])}, b = {sigmoidf_(v[4]), sigmoidf_(v[5]), sigmoidf_(v[6]), sigmoidf_(v[7])};
                            *(f32x4*)(GN + (size_t)row * 32 + fq * 8) = a; *(f32x4*)(GN + (size_t)row * 32 + fq * 8 + 4) = b;
                        }
                    }
                }
            }
        }
    }
};
template <int SECOND> struct EpiGate {
    static constexpr bool PERM = true, AFTER_DRAIN = false;
    const bf16_t* GM; bf16_t* TMP; bf16_t* OUT;
    __device__ __forceinline__ void operator()(const f32x4 (&acc)[2][2][4][2], const pg8::Unit& u, int wr, int wc, int fr, int fq) const {
#pragma unroll
        for (int ai = 0; ai < 2; ++ai) {
            u32x2 gv[4][2]; u32x4 tv[4][2];
#pragma unroll
            for (int m = 0; m < 4; ++m)
#pragma unroll
                for (int bj = 0; bj < 2; ++bj) {
                    const int row = u.pm * 256 + ai * 128 + wr * 64 + m * 16 + fr, col = u.pn * 256 + bj * 128 + wc * 32 + fq * 8;
                    gv[m][bj] = *(const u32x2*)((const unsigned char*)GM + (size_t)row * 2048 + SECOND * 1024 + col);
                    if (SECOND) tv[m][bj] = *(const u32x4*)(TMP + (size_t)row * 1024 + col);
                }
#pragma unroll
            for (int m = 0; m < 4; ++m)
#pragma unroll
                for (int bj = 0; bj < 2; ++bj) {
                    const int row = u.pm * 256 + ai * 128 + wr * 64 + m * 16 + fr, col = u.pn * 256 + bj * 128 + wc * 32 + fq * 8;
                    const u32x2 g = gv[m][bj];
                    float v[8];
#pragma unroll
                    for (int i = 0; i < 4; ++i) { v[i] = acc[ai][bj][m][0][i] * (float)((g.x >> (8 * i)) & 255u); v[4 + i] = acc[ai][bj][m][1][i] * (float)((g.y >> (8 * i)) & 255u); }
                    if (SECOND) {
                        const u32x4 t = tv[m][bj];
                        v[0] += bf_lo(t.x); v[1] += bf_hi(t.x); v[2] += bf_lo(t.y); v[3] += bf_hi(t.y); v[4] += bf_lo(t.z); v[5] += bf_hi(t.z); v[6] += bf_lo(t.w); v[7] += bf_hi(t.w);
                    }
                    u32x4 w; w.x = pk_bf16(v[0], v[1]); w.y = pk_bf16(v[2], v[3]); w.z = pk_bf16(v[4], v[5]); w.w = pk_bf16(v[6], v[7]);
                    *(u32x4*)(OUT + (size_t)row * 1024 + col) = w;
                }
        }
    }
};
struct EpiWo {
    static constexpr bool PERM = true, AFTER_DRAIN = false;
    const float* X; bf16_t* HB; float* ss;
    __device__ __forceinline__ void operator()(const f32x4 (&acc)[2][2][4][2], const pg8::Unit& u, int wr, int wc, int fr, int fq) const {
#pragma unroll
        for (int ai = 0; ai < 2; ++ai) {
            f32x4 xv[4][2][2];
#pragma unroll
            for (int m = 0; m < 4; ++m)
#pragma unroll
                for (int bj = 0; bj < 2; ++bj) {
                    const int row = u.pm * 256 + ai * 128 + wr * 64 + m * 16 + fr, col = u.pn * 256 + bj * 128 + wc * 32 + fq * 8;
                    xv[m][bj][0] = *(const f32x4*)(X + (size_t)row * DM + col); xv[m][bj][1] = *(const f32x4*)(X + (size_t)row * DM + col + 4);
                }
#pragma unroll
            for (int m = 0; m < 4; ++m) {
                const int row = u.pm * 256 + ai * 128 + wr * 64 + m * 16 + fr;
                float sq = 0.f;
#pragma unroll
                for (int bj = 0; bj < 2; ++bj) {
                    const int col = u.pn * 256 + bj * 128 + wc * 32 + fq * 8;
                    const f32x4 h0 = xv[m][bj][0] + acc[ai][bj][m][0], h1 = xv[m][bj][1] + acc[ai][bj][m][1];
                    sq += (h0[0] * h0[0] + h0[1] * h0[1]) + (h0[2] * h0[2] + h0[3] * h0[3]) + (h1[0] * h1[0] + h1[1] * h1[1]) + (h1[2] * h1[2] + h1[3] * h1[3]);
                    u32x4 w; w.x = pk_bf16(h0[0], h0[1]); w.y = pk_bf16(h0[2], h0[3]); w.z = pk_bf16(h1[0], h1[1]); w.w = pk_bf16(h1[2], h1[3]);
                    *(u32x4*)(HB + (size_t)row * DM + col) = w;
                }
                sq += __shfl_xor(sq, 16); sq += __shfl_xor(sq, 32);
                if (fq == 0) atomicAdd(ss + row, sq);
            }
        }
    }
};
struct EpiScores {
    static constexpr bool PERM = true, AFTER_DRAIN = false;
    const float* ss; unsigned short* SC;
    __device__ __forceinline__ void operator()(const f32x4 (&acc)[2][2][4][2], const pg8::Unit& u, int wr, int wc, int fr, int fq) const {
        float ssv[2][4];
#pragma unroll
        for (int ai = 0; ai < 2; ++ai)
#pragma unroll
            for (int m = 0; m < 4; ++m) ssv[ai][m] = ss[u.pm * 256 + ai * 128 + wr * 64 + m * 16 + fr];
#pragma unroll
        for (int ai = 0; ai < 2; ++ai)
#pragma unroll
            for (int m = 0; m < 4; ++m) {
                const int row = u.pm * 256 + ai * 128 + wr * 64 + m * 16 + fr;
                const float rs = rsqrtf(ssv[ai][m] * (1.0f / DM) + RMS_EPS);
#pragma unroll
                for (int bj = 0; bj < 2; ++bj) {
                    const int col = u.pn * 256 + bj * 128 + wc * 32 + fq * 8;
                    const f32x4 a = acc[ai][bj][m][0] * rs, b = acc[ai][bj][m][1] * rs;
                    u32x4 w; w.x = pk_f16(a[0], a[1]); w.y = pk_f16(a[2], a[3]); w.z = pk_f16(b[0], b[1]); w.w = pk_f16(b[2], b[3]);
                    *(u32x4*)(SC + (size_t)row * 2048 + col) = w;
                }
            }
    }
};

template <int NR>
__device__ __forceinline__ void convert_table_rows(const Params& P, int rr0, int lane) {
    unsigned char* ws = P.ws;
    f32x4 a[NR][4]; float ss[NR];
    f32x4 gq[4];
#pragma unroll
    for (int q = 0; q < 4; ++q) gq[q] = *(const f32x4*)(P.in[17] + lane * 16 + 4 * q);
#pragma unroll
    for (int u = 0; u < NR; ++u) {
        const int rr = rr0 + u, tbl = rr >= NEXP ? 1 : 0, r = rr - tbl * NEXP;
        const f32x4* sp = (const f32x4*)(P.in[21 + tbl] + (size_t)r * DM + lane * 16);
#pragma unroll
        for (int q = 0; q < 4; ++q) a[u][q] = tbl ? sp[q] : sp[q] * gq[q];
    }
#pragma unroll
    for (int u = 0; u < NR; ++u) { ss[u] = 0.f;
#pragma unroll
        for (int q = 0; q < 4; ++q) ss[u] += (a[u][q][0] * a[u][q][0] + a[u][q][1] * a[u][q][1]) + (a[u][q][2] * a[u][q][2] + a[u][q][3] * a[u][q][3]); }
#pragma unroll
    for (int u = 0; u < NR; ++u) {
        const int rr = rr0 + u, tbl = rr >= NEXP ? 1 : 0, r = rr - tbl * NEXP;
        const float rms = sqrtf(wave_sum(ss[u]) * (1.0f / DM));
        const float sc = (tbl ? 0.5f : 0.335f) * rms + 1e-30f, inv = 1.0f / sc;
        u32x2 o;
#pragma unroll
        for (int h = 0; h < 2; ++h) {
            unsigned w = 0u;
            if (tbl) {
                w = __builtin_amdgcn_cvt_scalef32_pk_fp4_f32(w, a[u][2 * h][0] * inv, a[u][2 * h][1] * inv, 1.0f, 0);
                w = __builtin_amdgcn_cvt_scalef32_pk_fp4_f32(w, a[u][2 * h][2] * inv, a[u][2 * h][3] * inv, 1.0f, 1);
                w = __builtin_amdgcn_cvt_scalef32_pk_fp4_f32(w, a[u][2 * h + 1][0] * inv, a[u][2 * h + 1][1] * inv, 1.0f, 2);
                w = __builtin_amdgcn_cvt_scalef32_pk_fp4_f32(w, a[u][2 * h + 1][2] * inv, a[u][2 * h + 1][3] * inv, 1.0f, 3);
            } else {
#pragma unroll
                for (int i = 0; i < 8; ++i) {
                    int q = (int)floorf(a[u][2 * h + (i >> 2)][i & 3] * inv);
                    q = q < -8 ? -8 : (q > 7 ? 7 : q);
                    w |= ((unsigned)q & 15u) << (4 * i);
                }
            }
            o[h] = w;
        }
        ((u32x2*)(ws + WS_UT) + tbl)[((size_t)r * 64 + lane) * 2] = o;
        if (lane == 0) ((float*)(ws + WS_TSC) + tbl * NEXP)[r] = sc;
    }
}
struct TableOrder : pg8::StaticOrder {
    const Params* P; int gw; mutable int calls;
    __device__ __forceinline__ void done(const pg8::Unit&) const {
        const int slot = gw * 4 + calls; ++calls;
        if (calls <= 4) convert_table_rows<4>(*P, slot * 4, (int)(threadIdx.x & 63));
    }
};
__device__ __forceinline__ int remap_win(int n) { return n < 2816 ? n : (n < 2840 ? 4864 + (n - 2816) : n - 24); }
template <int MODE>
__device__ __forceinline__ void transpose_item(const float* W, int K, int N, bf16_t* WT, LAS float* scr, int item, int lane, const unsigned* cmax = nullptr, float* wsc = nullptr) {
    const int nblk = (N + 31) / 32, kb = item / nblk, nb = item % nblk, k0 = 64 * kb, n0 = 32 * nb;
    const int nn = n0 + (lane & 31);
#pragma unroll 8
    for (int i = 0; i < 32; ++i) { const int kk = 2 * i + (lane >> 5); scr[kk * 33 + (lane & 31)] = (nn < N) ? W[(size_t)(k0 + kk) * N + nn] : 0.f; }
    asm volatile("s_waitcnt lgkmcnt(0)" ::: "memory");
    const int c = lane & 7;
#pragma unroll
    for (int j = 0; j < 4; ++j) {
        const int n = (lane >> 3) + 8 * j; const LAS float* s = scr + (8 * c) * 33 + n;
        constexpr float WSCALE = MODE == 3 ? 1.0f / 255.0f : 1.0f;
        u32x4 o; o.x = pk_bf16(s[0 * 33] * WSCALE, s[1 * 33] * WSCALE); o.y = pk_bf16(s[2 * 33] * WSCALE, s[3 * 33] * WSCALE); o.z = pk_bf16(s[4 * 33] * WSCALE, s[5 * 33] * WSCALE); o.w = pk_bf16(s[6 * 33] * WSCALE, s[7 * 33] * WSCALE);
        if constexpr (MODE == 2) {
            if (n0 + n < N) {
                const float cm = __uint_as_float(cmax[n0 + n]), sc = cm > 0.f ? 127.0f / cm : 0.f;
                unsigned w0 = 0u, w1 = 0u;
#pragma unroll
                for (int e = 0; e < 4; ++e) { const int q0 = (int)rintf(s[e * 33] * sc), q1 = (int)rintf(s[(4 + e) * 33] * sc); w0 |= ((unsigned)q0 & 255u) << (8 * e); w1 |= ((unsigned)q1 & 255u) << (8 * e); }
                const int dst = remap_win(n0 + n);
                *(u32x2*)((unsigned char*)WT + (size_t)dst * K + k0 + 8 * c) = (u32x2){w0, w1};
                if (k0 == 0 && c == 0) wsc[dst] = cm * (1.0f / 127.0f);
            }
        } else
        if (n0 + n < N) { const int dst = MODE == 1 ? remap_win(n0 + n) : (n0 + n); *(u32x4*)(WT + (size_t)dst * K + k0 + 8 * c) = o; }
    }
    asm volatile("s_waitcnt lgkmcnt(0)" ::: "memory");
}

__device__ __forceinline__ void p0_prep(const Params& P, LAS unsigned char* lds, int gw, int NGW, int wave, int lane, int part) {
    unsigned char* ws = P.ws;
    LAS float* scr = (LAS float*)(lds + wave * 16384);
    if (part == 0) {
        {
            constexpr int NB = (IN_COLS + 31) / 32;
            unsigned* cmax = (unsigned*)(ws + WS_CMAX);
            for (int it = gw; it < 16 * NB; it += NGW) {
                const int kb = it / NB, nb = it % NB, nn = 32 * nb + (lane & 31);
                const float* wp = P.in[2] + (size_t)(64 * kb + (lane >> 5)) * IN_COLS + nn;
                float mx = 0.f;
                if (nn < IN_COLS) {
#pragma unroll 8
                    for (int i = 0; i < 32; ++i) mx = fmaxf(mx, fabsf(wp[(size_t)(2 * i) * IN_COLS]));
                }
                mx = fmaxf(mx, swap32_other(mx));
                if (lane < 32 && nn < IN_COLS) atomicMax(cmax + nn, __float_as_uint(mx));
            }
        }
        return;
    }
    {
        constexpr int I_WIN = (1024 / 64) * ((IN_COLS + 31) / 32);
        for (int it = gw; it < I_WIN; it += NGW) transpose_item<2>(P.in[2], 1024, IN_COLS, (bf16_t*)(ws + WS_WIN_T), scr, it, lane, (const unsigned*)(ws + WS_CMAX), (float*)(ws + WS_WSC));
        u32x4* z = (u32x4*)(ws + WS_WIN_T + (size_t)IN_COLS * 1024);
        const int n16 = (NPAD - IN_COLS) * 1024 / 16;
        for (int i = gw * 64 + lane; i < n16; i += NGW * 64) z[i] = (u32x4){0u, 0u, 0u, 0u};
        if (gw == 0) for (int i = IN_COLS + lane; i < NPAD; i += 64) ((float*)(ws + WS_WSC))[i] = 0.f;
    }
    {
        constexpr int I_P = (512 / 64) * (1024 / 32), I_WO = (1024 / 64) * (1024 / 32), I_C1 = (2048 / 64) * (64 / 32), I_C2 = 1 * 2;
        constexpr int NITEMS = 2 * I_P + I_WO + 2 * I_C1 + 2 * I_C2;
        for (int it = gw; it < NITEMS; it += NGW) {
            int r = it;
            if (r < I_P) { transpose_item<3>(P.in[14], 512, 1024, (bf16_t*)(ws + WS_PDA_T), scr, r, lane); continue; } r -= I_P;
            if (r < I_P) { transpose_item<3>(P.in[15], 512, 1024, (bf16_t*)(ws + WS_PNSA_T), scr, r, lane); continue; } r -= I_P;
            if (r < I_WO) { transpose_item<0>(P.in[16], 1024, 1024, (bf16_t*)(ws + WS_WO_T), scr, r, lane); continue; } r -= I_WO;
            if (r < I_C1) { transpose_item<0>(P.in[10], 2048, 64, (bf16_t*)(ws + WS_CW1_T), scr, r, lane); continue; } r -= I_C1;
            if (r < I_C1) { transpose_item<0>(P.in[11], 2048, 64, (bf16_t*)(ws + WS_CW1_T) + 64 * 2048, scr, r, lane); continue; } r -= I_C1;
            if (r < I_C2) { transpose_item<0>(P.in[12], 64, 64, (bf16_t*)(ws + WS_CW2_T), scr, r, lane); continue; } r -= I_C2;
            transpose_item<0>(P.in[13], 64, 64, (bf16_t*)(ws + WS_CW2_T) + 64 * 64, scr, r, lane);
        }
    }
    {
        const float* wq = P.in[18]; bf16_t* WPT = (bf16_t*)(ws + WS_WP_T);
        const int i = lane & 31, kh = lane >> 5;
        for (int task = gw; task < 32 * 64; task += NGW) {
            const int jt = task >> 6, nt = task & 63, j0 = jt * 32, n0 = nt * 32;
            const int c = (n0 >> 7) & 1, k0 = n0 & 127, hc_off = n0 & ~127;
            const float* sk = c ? P.in[20] : P.in[19];
            const float* ap = wq + (size_t)(j0 + i) * 2048 + hc_off + 4 * kh;
            const float gj = P.in[17][j0 + i];
            const float* bp = sk + (size_t)(k0 + i) * 128 + 4 * kh;
            f32x16 acc = {0};
#pragma unroll 4
            for (int u = 0; u < 16; ++u) {
                const f32x4 a4 = *(const f32x4*)(ap + 8 * u) * gj, b4 = *(const f32x4*)(bp + 8 * u);
#pragma unroll
                for (int e = 0; e < 4; ++e) acc = __builtin_amdgcn_mfma_f32_32x32x2f32(a4[e], b4[e], acc, 0, 0, 0);
            }
#pragma unroll
            for (int g = 0; g < 4; ++g) {
                u32x2 o; o.x = pk_bf16(acc[4 * g + 0], acc[4 * g + 1]); o.y = pk_bf16(acc[4 * g + 2], acc[4 * g + 3]);
                *(u32x2*)(WPT + (size_t)(n0 + i) * 1024 + j0 + 8 * g + 4 * kh) = o;
            }
        }
    }
    {
        float* rope = (float*)(ws + WS_ROPE);
        for (int idx = gw * 64 + lane; idx < SEQ * 8; idx += NGW * 64) {
            const int pos = idx >> 3, i = idx & 7;
            const float inv = (float)pow(500000.0, -(double)i / 8.0);
            const float ang = (float)pos * inv;
            rope[pos * 16 + i] = (float)cos((double)ang); rope[pos * 16 + 8 + i] = (float)sin((double)ang);
        }
    }
    {
        float* misc = (float*)(ws + WS_MISC);
        for (int task = gw; task < 128; task += NGW) {
            const int t = task >> 6, n = task & 63; const float* pe = P.in[8 + t]; const float* w1 = P.in[10 + t];
            float s = 0.f;
            for (int kk = lane; kk < 2048; kk += 64) s += pe[kk] * w1[(size_t)kk * 64 + n];
            s = wave_sum(s);
            if (lane == 0) misc[64 + task] = s;
        }
        if (gw == 0) {
            float a = P.in[3][lane] * P.in[4][lane], b = P.in[5][lane] * P.in[6][lane];
            a = wave_sum(a); b = wave_sum(b);
            if (lane == 0) misc[0] = __expf(a) - __expf(b) + LAMBDA_INIT;
        }
        float* ss = (float*)(ws + WS_SS);
        for (int i = gw * 64 + lane; i < NT; i += NGW * 64) ss[i] = 0.f;
    }
    {
        const float* gn = P.in[1]; bf16_t* A = (bf16_t*)(ws + WS_A);
        f32x4 g[4];
#pragma unroll
        for (int j = 0; j < 4; ++j) g[j] = ((const f32x4*)gn)[64 * j + lane];
        for (int mrow = gw; mrow < NT; mrow += 2 * NGW) {
            const f32x4* xr0 = (const f32x4*)(P.in[0] + (size_t)mrow * DM) + lane; const f32x4* xr1 = (const f32x4*)(P.in[0] + (size_t)(mrow + NGW) * DM) + lane;
            f32x4 v0[4], v1[4]; float s0 = 0.f, s1 = 0.f;
#pragma unroll
            for (int j = 0; j < 4; ++j) { v0[j] = xr0[64 * j]; v1[j] = xr1[64 * j]; }
#pragma unroll
            for (int j = 0; j < 4; ++j) { s0 += (v0[j][0] * v0[j][0] + v0[j][1] * v0[j][1]) + (v0[j][2] * v0[j][2] + v0[j][3] * v0[j][3]); s1 += (v1[j][0] * v1[j][0] + v1[j][1] * v1[j][1]) + (v1[j][2] * v1[j][2] + v1[j][3] * v1[j][3]); }
            const float rs0 = rsqrtf(wave_sum(s0) * (1.0f / DM) + RMS_EPS), rs1 = rsqrtf(wave_sum(s1) * (1.0f / DM) + RMS_EPS);
            float m0 = 0.f, m1 = 0.f;
#pragma unroll
            for (int j = 0; j < 4; ++j)
#pragma unroll
                for (int e = 0; e < 4; ++e) { v0[j][e] *= rs0 * g[j][e]; v1[j][e] *= rs1 * g[j][e]; m0 = fmaxf(m0, fabsf(v0[j][e])); m1 = fmaxf(m1, fabsf(v1[j][e])); }
            m0 = wave_max(m0); m1 = wave_max(m1);
            const float q0 = m0 > 0.f ? 127.0f / m0 : 0.f, q1 = m1 > 0.f ? 127.0f / m1 : 0.f;
            unsigned* o0 = (unsigned*)((unsigned char*)A + (size_t)mrow * DM) + lane; unsigned* o1 = (unsigned*)((unsigned char*)A + (size_t)(mrow + NGW) * DM) + lane;
#pragma unroll
            for (int j = 0; j < 4; ++j) {
                unsigned a = 0u, b = 0u;
#pragma unroll
                for (int e = 0; e < 4; ++e) { a |= ((unsigned)(int)rintf(v0[j][e] * q0) & 255u) << (8 * e); b |= ((unsigned)(int)rintf(v1[j][e] * q1) & 255u) << (8 * e); }
                o0[64 * j] = a; o1[64 * j] = b;
            }
            if (lane == 0) { ((float*)(ws + WS_ASC))[mrow] = m0 * (1.0f / 127.0f); ((float*)(ws + WS_ASC))[mrow + NGW] = m1 * (1.0f / 127.0f); }
        }
    }
}

__device__ __forceinline__ void compress_tasks(const Params& P, LAS unsigned char* lds, int wgid, int wave, int lane) {
    unsigned char* ws = P.ws;
    const bf16_t* ZA = (const bf16_t*)(ws + WS_ZA);
    const float* misc = (const float*)(ws + WS_MISC);
    typedef float f32x4v __attribute__((ext_vector_type(4)));
    const int task = 2 * wgid + (wave >> 2), kch = wave & 3;
    const int t = task >> 8, rem = task & 255, b = rem >> 5, g = (rem >> 4) & 1, nt = rem & 15;
    const int m = lane & 15, q = lane >> 4;
    const int n = nt * 16 + m, ne = n < 255 ? n : 254;
    const bf16_t* W1T = (const bf16_t*)(ws + WS_CW1_T) + (size_t)t * 64 * 2048;
    const bf16_t* src = ZA + (size_t)(b * SEQ + 16 * ne) * ZP + (t ? ZC_VC : ZC_KC) + g * 64;
    f32x4v d1[4];
#pragma unroll
    for (int i = 0; i < 4; ++i) d1[i] = (f32x4v){0.f, 0.f, 0.f, 0.f};
    if (task < 512) {
        bf16x8 fb[16];
#pragma unroll
        for (int kk = 0; kk < 16; ++kk) { const int k = kch * 512 + kk * 32 + 8 * q; fb[kk] = *(const bf16x8*)(src + (size_t)(k >> 6) * ZP + (k & 63)); }
#pragma unroll
        for (int kk = 0; kk < 16; ++kk) {
            const int k = kch * 512 + kk * 32 + 8 * q;
#pragma unroll
            for (int t4 = 0; t4 < 4; ++t4) {
                const bf16x8 wa = *(const bf16x8*)(W1T + (size_t)(16 * t4 + m) * 2048 + k);
                d1[t4] = __builtin_amdgcn_mfma_f32_16x16x32_bf16(wa, fb[kk], d1[t4], 0, 0, 0);
            }
        }
    }
    LAS float* part = (LAS float*)lds;
#pragma unroll
    for (int t4 = 0; t4 < 4; ++t4)
#pragma unroll
        for (int r = 0; r < 4; ++r) part[(wave * 16 + t4 * 4 + r) * 64 + lane] = d1[t4][r];
    __syncthreads();
    if (kch == 0 && task < 512) {
        const int w0 = wave;
        float gl[4][4];
#pragma unroll
        for (int t4 = 0; t4 < 4; ++t4)
#pragma unroll
            for (int r = 0; r < 4; ++r) {
                float s = 0.f;
#pragma unroll
                for (int w = 0; w < 4; ++w) s += part[((w0 + w) * 16 + t4 * 4 + r) * 64 + lane];
                s += misc[64 + t * 64 + 16 * t4 + 4 * q + r];
                gl[t4][r] = gelu_poly(s);
            }
        const bf16_t* W2T = (const bf16_t*)(ws + WS_CW2_T) + (size_t)t * 64 * 64;
        f32x4v d2[4];
#pragma unroll
        for (int i = 0; i < 4; ++i) d2[i] = (f32x4v){0.f, 0.f, 0.f, 0.f};
#pragma unroll
        for (int s = 0; s < 2; ++s) {
            u32x4 bw; bw.x = pk_bf16(gl[2 * s][0], gl[2 * s][1]); bw.y = pk_bf16(gl[2 * s][2], gl[2 * s][3]); bw.z = pk_bf16(gl[2 * s + 1][0], gl[2 * s + 1][1]); bw.w = pk_bf16(gl[2 * s + 1][2], gl[2 * s + 1][3]);
            const bf16x8 gb = __builtin_bit_cast(bf16x8, bw);
#pragma unroll
            for (int t2 = 0; t2 < 4; ++t2) {
                const bf16_t* wp = W2T + (size_t)(16 * t2 + m) * 64 + 32 * s + 4 * q;
                const u32x2 lo = *(const u32x2*)wp, hi = *(const u32x2*)(wp + 16);
                u32x4 aw; aw.x = lo.x; aw.y = lo.y; aw.z = hi.x; aw.w = hi.y;
                d2[t2] = __builtin_amdgcn_mfma_f32_16x16x32_bf16(__builtin_bit_cast(bf16x8, aw), gb, d2[t2], 0, 0, 0);
            }
        }
        bf16_t* KC = (bf16_t*)(ws + WS_KC) + (size_t)t * (NB * 2 * 256 * 64) + (size_t)((b * 2 + g) * 256 + n) * 64;
#pragma unroll
        for (int t2 = 0; t2 < 4; ++t2) {
            u32x2 o; o.x = pk_bf16(d2[t2][0], d2[t2][1]); o.y = pk_bf16(d2[t2][2], d2[t2][3]);
            if (n >= 255) { o.x = 0u; o.y = 0u; }
            *(u32x2*)(KC + 16 * t2 + 4 * q) = o;
        }
    }
    __syncthreads();
}

namespace att {
constexpr int K_BYTES = 8192, V_BYTES = 16384;
constexpr int OFF_RING = 0;
constexpr int OFF_K0 = 0;
constexpr int OFF_WSF = 73728;
constexpr int OFF_IMP = OFF_WSF + NWAVES * 64 * 4;
constexpr int OFF_SELM = OFF_IMP + 4 * 64 * 65 * 4;
constexpr int OFF_END = OFF_SELM + 512;
static_assert(OFF_END <= LDS_BYTES - 256, "attention LDS map");
__device__ __forceinline__ int crow(int r, int hi) { return (r & 3) + 8 * (r >> 2) + 4 * hi; }
typedef short v4i16_t __attribute__((ext_vector_type(4)));
__device__ __forceinline__ s16x4 vtr(const LAS unsigned char* p) { return __builtin_bit_cast(s16x4, __builtin_amdgcn_ds_read_tr16_b64_v4i16((LAS v4i16_t*)p)); }

template <int NDB> struct Stage { u32x4 k; u32x4 v[NDB / 2]; };
template <int NDB>
__device__ __forceinline__ void stage_load(Stage<NDB>& s, const bf16_t* Kg, const bf16_t* Vg, int pitch, int j, int tid) {
    const int key = tid >> 3, ch = tid & 7;
    s.k = *(const u32x4*)(Kg + (size_t)(j * 64 + key) * pitch + ch * 8);
    if constexpr (NDB == 2) { s.v[0] = *(const u32x4*)(Vg + (size_t)(j * 64 + key) * pitch + ch * 8); }
    else {
#pragma unroll
        for (int p = 0; p < 2; ++p) { const int row = p * 32 + (tid >> 4), c16 = tid & 15; s.v[p] = *(const u32x4*)(Vg + (size_t)(j * 64 + row) * pitch + c16 * 8); }
    }
}
template <int NDB>
__device__ __forceinline__ void stage_store(const Stage<NDB>& s, LAS unsigned char* Kb, LAS unsigned char* Vb, int tid) {
    const int key = tid >> 3, ch = tid & 7;
    *(LAS u32x4*)(Kb + ch * 1024 + ((key ^ ch) << 4)) = s.k;
    if constexpr (NDB == 2) { *(LAS u32x4*)(Vb + (ch >> 2) * 4096 + (key >> 4) * 1024 + (key & 15) * 64 + (ch & 3) * 16) = s.v[0]; }
    else {
#pragma unroll
        for (int p = 0; p < 2; ++p) { const int row = p * 32 + (tid >> 4), c16 = tid & 15; *(LAS u32x4*)(Vb + (c16 >> 2) * 4096 + (row >> 4) * 1024 + (row & 15) * 64 + (c16 & 3) * 16) = s.v[p]; }
    }
}
__device__ __forceinline__ void tile_scores(f32x16& p0, f32x16& p1, const LAS unsigned char* Kb, const bf16x8 (&qr)[4], int kvbase, int lob, int hib, int lane) {
    const int r32 = lane & 31, hi = lane >> 5;
    p0 = (f32x16){0.f}; p1 = (f32x16){0.f};
    bf16x8 kf0[4], kf1[4];
#pragma unroll
    for (int d0 = 0; d0 < 4; ++d0) {
        const int c = 2 * d0 + hi;
        const LAS unsigned char* kp = Kb + c * 1024 + ((r32 ^ c) << 4);
        kf0[d0] = *(const LAS bf16x8*)kp; kf1[d0] = *(const LAS bf16x8*)(kp + 512);
    }
    __builtin_amdgcn_sched_barrier(0);
#pragma unroll
    for (int d0 = 0; d0 < 4; ++d0) {
        p0 = __builtin_amdgcn_mfma_f32_32x32x16_bf16(kf0[d0], qr[d0], p0, 0, 0, 0);
        p1 = __builtin_amdgcn_mfma_f32_32x32x16_bf16(kf1[d0], qr[d0], p1, 0, 0, 0);
    }
    const bool allv = (kvbase + 63 <= hib) && (kvbase > lob);
    if (!__all(allv)) {
#pragma unroll
        for (int r = 0; r < 16; ++r) {
            const int kv = kvbase + crow(r, hi);
            if (kv > hib || kv <= lob) p0[r] = -INFINITY;
            if (kv + 32 > hib || kv + 32 <= lob) p1[r] = -INFINITY;
        }
    }
}
__device__ __forceinline__ float max3f(float a, float b, float c) { return __builtin_fmaxf(__builtin_fmaxf(a, b), c); }
__device__ __forceinline__ float rowmax32(const f32x16& p0, const f32x16& p1) {
    float a = max3f(p0[0], p0[1], p1[0]), b = max3f(p0[2], p0[3], p1[1]); a = max3f(a, p1[2], p1[3]);
#pragma unroll
    for (int r = 4; r < 16; r += 4) { a = max3f(a, p0[r], p0[r + 1]); b = max3f(b, p0[r + 2], p0[r + 3]); a = max3f(a, p1[r], p1[r + 1]); b = max3f(b, p1[r + 2], p1[r + 3]); }
    a = __builtin_fmaxf(a, b);
    return __builtin_fmaxf(a, swap32_other(a));
}
template <int NDB>
__device__ __forceinline__ void tile_compute(const LAS unsigned char* Kb, const LAS unsigned char* Vb, const bf16x8 (&qr)[4], float& m, float& l, f32x16 (&o)[NDB], LAS float* wsf, int kvbase, int lob, int hib, int lane, bool lanesel = true) {
    const int hi = lane >> 5, r32 = lane & 31;
    f32x16 p0, p1;
    tile_scores(p0, p1, Kb, qr, kvbase, lob, hib, lane);
    const float rm = lanesel ? rowmax32(p0, p1) : -INFINITY;
    const float mn = fmaxf(m, rm);
    if (__any(mn > m + 8.0f)) {
        const float alpha = __builtin_amdgcn_exp2f(m - mn);
        l *= alpha; m = mn;
        if (hi == 0) wsf[r32] = alpha;
#pragma unroll
        for (int g = 0; g < 4; ++g) {
            const f32x4 a4 = *(const LAS f32x4*)(wsf + 8 * g + 4 * hi);
#pragma unroll
            for (int db = 0; db < NDB; ++db) { o[db][4 * g + 0] *= a4[0]; o[db][4 * g + 1] *= a4[1]; o[db][4 * g + 2] *= a4[2]; o[db][4 * g + 3] *= a4[3]; }
        }
    }
    {
        const float msub = lanesel ? m : INFINITY;
        const f32x2 m2 = {msub, msub};
        f32x2 sa = {0.f, 0.f}, sb = {0.f, 0.f};
#pragma unroll
        for (int r = 0; r < 16; r += 2) {
            f32x2 t0 = (f32x2){p0[r], p0[r + 1]} - m2, t1 = (f32x2){p1[r], p1[r + 1]} - m2;
            t0.x = __builtin_amdgcn_exp2f(t0.x); t0.y = __builtin_amdgcn_exp2f(t0.y); t1.x = __builtin_amdgcn_exp2f(t1.x); t1.y = __builtin_amdgcn_exp2f(t1.y);
            sa += t0; sb += t1;
            p0[r] = t0.x; p0[r + 1] = t0.y; p1[r] = t1.x; p1[r + 1] = t1.y;
        }
        sa += sb;
        l += sa.x + sa.y;
    }
    u32x4 pw[4];
#pragma unroll
    for (int k = 0; k < 2; ++k) {
        pw[k] = (u32x4){pk_bf16(p0[8 * k + 0], p0[8 * k + 1]), pk_bf16(p0[8 * k + 2], p0[8 * k + 3]), pk_bf16(p0[8 * k + 4], p0[8 * k + 5]), pk_bf16(p0[8 * k + 6], p0[8 * k + 7])};
        pw[2 + k] = (u32x4){pk_bf16(p1[8 * k + 0], p1[8 * k + 1]), pk_bf16(p1[8 * k + 2], p1[8 * k + 3]), pk_bf16(p1[8 * k + 4], p1[8 * k + 5]), pk_bf16(p1[8 * k + 6], p1[8 * k + 7])};
    }
    const LAS unsigned char* vp = Vb + ((lane >> 4) & 1) * 32 + (lane & 3) * 8 + (4 * hi + ((lane & 15) >> 2)) * 64;
    s16x4 vlo[2][4], vhh[2][4];
#pragma unroll
    for (int ks = 0; ks < 4; ++ks) { vlo[0][ks] = vtr(vp + ks * 1024); vhh[0][ks] = vtr(vp + ks * 1024 + 512); }
#pragma unroll
    for (int db = 0; db < NDB; ++db) {
        if (NDB == 4 && db + 1 < NDB) {
#pragma unroll
            for (int ks = 0; ks < 4; ++ks) { vlo[(db + 1) & 1][ks] = vtr(vp + (db + 1) * 4096 + ks * 1024); vhh[(db + 1) & 1][ks] = vtr(vp + (db + 1) * 4096 + ks * 1024 + 512); }
        }
        if (NDB != 4 && db > 0) {
#pragma unroll
            for (int ks = 0; ks < 4; ++ks) { vlo[db & 1][ks] = vtr(vp + db * 4096 + ks * 1024); vhh[db & 1][ks] = vtr(vp + db * 4096 + ks * 1024 + 512); }
        }
        __builtin_amdgcn_sched_barrier(0);
#pragma unroll
        for (int ks = 0; ks < 4; ++ks) {
            const s16x4 lo = vlo[db & 1][ks], hh = vhh[db & 1][ks];
            const bf16x8 vf = (bf16x8){lo[0], lo[1], lo[2], lo[3], hh[0], hh[1], hh[2], hh[3]};
            o[db] = __builtin_amdgcn_mfma_f32_32x32x16_bf16(__builtin_bit_cast(bf16x8, pw[ks]), vf, o[db], 0, 0, 0);
        }
        __builtin_amdgcn_sched_barrier(0);
    }
}
__device__ __forceinline__ void glds16(const bf16_t* gsrc, LAS unsigned char* lds_dst) {
    unsigned keep; const unsigned dst = (unsigned)__builtin_amdgcn_readfirstlane((int)(unsigned)(size_t)lds_dst);
    asm volatile("s_mov_b32 %0, m0\n\ts_mov_b32 m0, %2\n\ts_nop 0\n\tglobal_load_lds_dwordx4 %1, off\n\ts_mov_b32 m0, %0" : "=&s"(keep) : "v"(gsrc), "s"(dst) : "memory");
}
#define ATT_WAIT_BAR(N) asm volatile("s_waitcnt vmcnt(" #N ") lgkmcnt(0)\n\ts_barrier" ::: "memory")
template <int NDB, bool SEL>
__device__ __forceinline__ void stream(LAS unsigned char* lds, const bf16_t* Kg, const bf16_t* Vg, int pitch, int ntiles, int j0, unsigned long long tilemask, unsigned long long mymask, int lob, int hib,
                                       const bf16x8 (&qr)[4], float& m, float& l, f32x16 (&o)[NDB], LAS float* wsf, int tid, int lane, int wave) {
    constexpr int SLOT = K_BYTES + NDB * 4096;
    const bf16_t* ksrc = Kg + (size_t)(lane ^ wave) * pitch + wave * 8;
    const bf16_t* vsrc0 = Vg + (size_t)(16 * (wave & 3) + (lane >> 2)) * pitch + (wave >> 2) * 32 + (lane & 3) * 8;
    const size_t tstep = (size_t)64 * pitch;
    auto issue = [&](int j, int slot) {
        LAS unsigned char* base = lds + OFF_RING + slot * SLOT;
        glds16(ksrc + (size_t)j * tstep, base + wave * 1024);
        glds16(vsrc0 + (size_t)j * tstep, base + K_BYTES + wave * 1024);
        if constexpr (NDB == 4) glds16(vsrc0 + (size_t)j * tstep + 64, base + K_BYTES + (wave + 8) * 1024);
    };
    unsigned long long rem = tilemask;
    int jseq = j0;
    auto nextj = [&]() -> int { if constexpr (SEL) { const int j = __ffsll((long long)rem) - 1; rem &= rem - 1; return j; } else { return jseq++; } };
    asm volatile("s_waitcnt vmcnt(0)" ::: "memory");
    int jc = nextj(), jn = 0;
    issue(jc, 0);
    if (ntiles > 1) { jn = nextj(); issue(jn, 1); }
    if (ntiles > 1) { if constexpr (NDB == 4) ATT_WAIT_BAR(3); else ATT_WAIT_BAR(2); } else ATT_WAIT_BAR(0);
    int hib_min = hib;
    if constexpr (SEL) { hib_min = __builtin_amdgcn_readfirstlane(hib - (lane & 31)); }
    int slot = 0;
#pragma nounroll
    for (int i = 0; i < ntiles; ++i) {
        int jn2 = 0;
        const bool more2 = i + 2 < ntiles;
        if (more2) { jn2 = nextj(); issue(jn2, slot == 0 ? 2 : slot - 1); }
        const LAS unsigned char* Kb = lds + OFF_RING + slot * SLOT;
        if constexpr (SEL) {
            const bool sel = ((mymask >> jc) & 1ull) != 0ull;
            if (jc * 64 + 63 <= hib_min) tile_compute<NDB>(Kb, Kb + K_BYTES, qr, m, l, o, wsf, jc * 64, lob, 0x7fffffff, lane, sel);
            else tile_compute<NDB>(Kb, Kb + K_BYTES, qr, m, l, o, wsf, jc * 64, lob, sel ? hib : -1, lane);
        } else {
            tile_compute<NDB>(Kb, Kb + K_BYTES, qr, m, l, o, wsf, jc * 64, lob, hib, lane);
        }
        if (more2) { if constexpr (NDB == 4) ATT_WAIT_BAR(3); else ATT_WAIT_BAR(2); } else ATT_WAIT_BAR(0);
        jc = jn; jn = jn2; slot = slot == 2 ? 0 : slot + 1;
    }
}
template <int NDB>
__device__ __forceinline__ void fold(f32x16 (&acc)[NDB], const f32x16 (&o)[NDB], float coef, LAS float* wsf, int lane, bool first) {
    const int hi = lane >> 5, r32 = lane & 31;
    if (hi == 0) wsf[32 + r32] = coef;
#pragma unroll
    for (int g = 0; g < 4; ++g) {
        const f32x4 c4 = *(const LAS f32x4*)(wsf + 32 + 8 * g + 4 * hi);
#pragma unroll
        for (int db = 0; db < NDB; ++db)
#pragma unroll
            for (int e = 0; e < 4; ++e) acc[db][4 * g + e] = first ? o[db][4 * g + e] * c4[e] : acc[db][4 * g + e] + o[db][4 * g + e] * c4[e];
    }
}
}

__device__ __forceinline__ void da_unit(const Params& P, LAS unsigned char* lds, int b, int h, int qb, int tid, int lane, int wave) {
    asm volatile("" : "+v"(tid), "+v"(lane));
    unsigned char* ws = P.ws;
    const bf16_t* Z = (const bf16_t*)(ws + WS_ZA) + (size_t)b * SEQ * ZP;
    const int r32 = lane & 31, hi = lane >> 5;
    const int q0 = qb * 256, qpos = q0 + wave * 32 + r32;
    LAS float* wsf = (LAS float*)(lds + att::OFF_WSF) + wave * 64;
    const int ntiles = (q0 + 256) / 64;
    unsigned o1p[4][8];
    f32x16 o[4]; float cf[16];
#pragma nounroll
    for (int comp = 0; comp < 2; ++comp) {
        bf16x8 qr[4];
#pragma unroll
        for (int d0 = 0; d0 < 4; ++d0) qr[d0] = *(const bf16x8*)(Z + (size_t)qpos * ZP + ZC_QDA + h * 128 + comp * 64 + d0 * 16 + hi * 8);
        asm volatile("" : "+v"(qr[0]), "+v"(qr[1]), "+v"(qr[2]), "+v"(qr[3]));
        float m = -1e30f, l = 0.f;
#pragma unroll
        for (int i = 0; i < 4; ++i) o[i] = (f32x16){0.f};
        att::stream<4, false>(lds, Z + ZC_KDA + h * 128 + comp * 64, Z + ZC_VDA + h * 128, ZP, ntiles, 0, 0ull, 0ull, -0x7fffffff, qpos, qr, m, l, o, wsf, tid, lane, wave);
        const float lt = l + swap32_other(l);
        const float coef = 1.0f / lt;
        if (hi == 0) wsf[32 + r32] = coef;
#pragma unroll
        for (int g = 0; g < 4; ++g) { const f32x4 c4 = *(const LAS f32x4*)(wsf + 32 + 8 * g + 4 * hi); cf[4 * g] = c4[0]; cf[4 * g + 1] = c4[1]; cf[4 * g + 2] = c4[2]; cf[4 * g + 3] = c4[3]; }
        if (comp == 0) {
#pragma unroll
            for (int db = 0; db < 4; ++db)
#pragma unroll
                for (int r = 0; r < 8; ++r) o1p[db][r] = pk_bf16(o[db][2 * r] * cf[2 * r], o[db][2 * r + 1] * cf[2 * r + 1]);
        }
    }
    const float lam = ((const float*)(ws + WS_MISC))[0];
    const float* subln = P.in[7];
    float sl[4];
#pragma unroll
    for (int db = 0; db < 4; ++db) sl[db] = subln[32 * db + r32] * (1.0f - LAMBDA_INIT);
    bf16_t* Y = (bf16_t*)(ws + WS_YDA) + (size_t)(b * SEQ + q0 + wave * 32 + 4 * hi) * 512 + h * 128 + r32;
    asm volatile("" : "+v"(Y));
#pragma unroll
    for (int r = 0; r < 16; ++r) {
        float v[4];
#pragma unroll
        for (int db = 0; db < 4; ++db) v[db] = ((r & 1) ? bf_hi(o1p[db][r >> 1]) : bf_lo(o1p[db][r >> 1])) - lam * o[db][r] * cf[r];
        float s = v[0] * v[0] + v[1] * v[1] + v[2] * v[2] + v[3] * v[3];
        s = row16_sum(s); s += swz16f(s);
        const float rs = rsqrtf(s * (1.0f / 128.0f) + RMS_EPS);
        const int qrow = (r & 3) + 8 * (r >> 2);
#pragma unroll
        for (int db = 0; db < 4; ++db) ((__attribute__((address_space(1))) bf16_t*)Y)[(size_t)qrow * 512 + 32 * db] = (bf16_t)(pk_bf16(v[db] * rs * sl[db], 0.f) & 0xffffu);
    }
}

__device__ __forceinline__ void nsa_unit(const Params& P, LAS unsigned char* lds, int b, int g, int ib, int tid, int lane, int wave) {
    asm volatile("" : "+v"(tid), "+v"(lane));
    unsigned char* ws = P.ws;
    const bf16_t* Z = (const bf16_t*)(ws + WS_ZA) + (size_t)b * SEQ * ZP;
    const int r32 = lane & 31, hi = lane >> 5;
    const int hh = wave >> 1, head = g * 4 + hh, ql = (wave & 1) * 32 + r32, qpos = ib * 64 + ql;
    LAS float* wsf = (LAS float*)(lds + att::OFF_WSF) + wave * 64;
    LAS float* imp = (LAS float*)(lds + att::OFF_IMP);
    LAS unsigned long long* selm = (LAS unsigned long long*)(lds + att::OFF_SELM);
    const float* gn = (const float*)(ws + WS_GN) + (size_t)(b * SEQ + qpos) * 32 + head * 3;
    float g0 = gn[0], g1 = gn[1], g2 = gn[2];
    asm volatile("" : "+v"(g0), "+v"(g1), "+v"(g2));
    bf16x8 qr[4];
#pragma unroll
    for (int d0 = 0; d0 < 4; ++d0) qr[d0] = *(const bf16x8*)(Z + (size_t)qpos * ZP + ZC_QN + head * 64 + d0 * 16 + hi * 8);
    asm volatile("" : "+v"(qr[0]), "+v"(qr[1]), "+v"(qr[2]), "+v"(qr[3]));
    for (int i = tid; i < 4 * 64 * 65; i += 512) imp[i] = 0.f;
    f32x16 res[2];
    const bf16_t* KC = (const bf16_t*)(ws + WS_KC) + (size_t)((b * 2 + g) * 256) * 64;
    const bf16_t* VC = KC + (size_t)NB * 2 * 256 * 64;
    const int nmax = qpos >= 31 ? (((qpos - 31) >> 4) < 254 ? ((qpos - 31) >> 4) : 254) : -1;
    const int ntc = ((4 * ib + 2) >> 6) + 1;
    float mc, invl;
    {
        float m = -1e30f, l = 0.f; f32x16 o[2]; o[0] = (f32x16){0.f}; o[1] = (f32x16){0.f};
        att::stream<2, false>(lds, KC, VC, 64, ntc, 0, 0ull, 0ull, -0x7fffffff, nmax, qr, m, l, o, wsf, tid, lane, wave);
        const float lt = l + swap32_other(l);
        invl = lt > 0.f ? 1.0f / lt : 0.f; mc = m;
        att::fold<2>(res, o, g0 * invl, wsf, lane, true);
    }
    {
        float carry = 0.f;
        att::Stage<2> st;
        for (int jt = 0; jt < ntc; ++jt) {
            st.k = *(const u32x4*)(KC + (size_t)(jt * 64 + (tid >> 3)) * 64 + (tid & 7) * 8);
            { const int key = tid >> 3, ch = tid & 7; *(LAS u32x4*)(lds + att::OFF_K0 + ch * 1024 + ((key ^ ch) << 4)) = st.k; }
            __syncthreads();
            f32x16 p0, p1;
            att::tile_scores(p0, p1, lds + att::OFF_K0, qr, jt * 64, -0x7fffffff, nmax, lane);
            float G[8], E[8];
#pragma unroll
            for (int kk = 0; kk < 4; ++kk) {
                float a0 = __builtin_amdgcn_exp2f(p0[4 * kk + 0] - mc) * invl, a1 = __builtin_amdgcn_exp2f(p0[4 * kk + 1] - mc) * invl, a2 = __builtin_amdgcn_exp2f(p0[4 * kk + 2] - mc) * invl, a3 = __builtin_amdgcn_exp2f(p0[4 * kk + 3] - mc) * invl;
                G[kk] = (a0 + a1) + (a2 + a3); E[kk] = a3;
                float b0 = __builtin_amdgcn_exp2f(p1[4 * kk + 0] - mc) * invl, b1 = __builtin_amdgcn_exp2f(p1[4 * kk + 1] - mc) * invl, b2 = __builtin_amdgcn_exp2f(p1[4 * kk + 2] - mc) * invl, b3 = __builtin_amdgcn_exp2f(p1[4 * kk + 3] - mc) * invl;
                G[4 + kk] = (b0 + b1) + (b2 + b3); E[4 + kk] = b3;
            }
            float X[8];
#pragma unroll
            for (int kk = 0; kk < 8; ++kk) X[kk] = swap32_other(E[kk]);
#pragma unroll
            for (int kk = 0; kk < 8; ++kk) {
                const float prev = hi ? X[kk] : (kk == 0 ? carry : X[kk - 1]);
                const int s = 16 * jt + 2 * kk + hi;
                imp[(hh * 64 + s) * 65 + ql] = G[kk] + prev;
            }
            carry = X[7];
            __syncthreads();
        }
    }
    __syncthreads();
    {
        const int s = lane;
        const bool valid = s <= ib, forced = (s == 0) || (s == ib) || (s == ib - 1);
#pragma nounroll
        for (int qq = 0; qq < 8; ++qq) {
            const int q = wave * 8 + qq;
            const float v = imp[(0 * 64 + s) * 65 + q] + imp[(1 * 64 + s) * 65 + q] + imp[(2 * 64 + s) * 65 + q] + imp[(3 * 64 + s) * 65 + q];
            bool sel;
            if (ib + 1 <= 16) sel = valid;
            else {
                const bool cand = valid && !forced;
                const unsigned key = cand ? (((__float_as_uint(v) & ~63u) + 64u) | (unsigned)(63 - s)) : 0u;
                LAS unsigned* wsu = (LAS unsigned*)wsf;
                wsu[s] = key;
                int rank = 0;
#pragma unroll
                for (int s4 = 0; s4 < 16; ++s4) {
                    const u32x4 k4 = *(const LAS u32x4*)(wsu + 4 * s4);
#pragma unroll
                    for (int e = 0; e < 4; ++e) rank += (k4[e] > key) ? 1 : 0;
                }
                sel = forced || (cand && rank < 13);
            }
            const unsigned long long mk = __ballot(sel);
            if (lane == 0) selm[q] = mk;
        }
    }
    __syncthreads();
    const unsigned long long mymask = selm[ql];
    unsigned long long uni = 0ull;
    for (int q = 0; q < 64; ++q) uni |= selm[q];
    uni = ((unsigned long long)(unsigned)__builtin_amdgcn_readfirstlane((int)(uni >> 32)) << 32) | (unsigned)__builtin_amdgcn_readfirstlane((int)(uni & 0xffffffffull));
    {
        float m = -1e30f, l = 0.f; f32x16 o[2]; o[0] = (f32x16){0.f}; o[1] = (f32x16){0.f};
        const int nts = __popcll(uni);
        att::stream<2, true>(lds, Z + ZC_KS + g * 64, Z + ZC_VS + g * 64, ZP, nts, 0, uni, mymask, -0x7fffffff, qpos, qr, m, l, o, wsf, tid, lane, wave);
        const float lt = l + swap32_other(l);
        att::fold<2>(res, o, lt > 0.f ? g1 / lt : 0.f, wsf, lane, false);
    }
    {
        float m = -1e30f, l = 0.f; f32x16 o[2]; o[0] = (f32x16){0.f}; o[1] = (f32x16){0.f};
        const int j0 = ib >= 8 ? ib - 8 : 0;
        att::stream<2, false>(lds, Z + ZC_KW + g * 64, Z + ZC_VW + g * 64, ZP, ib - j0 + 1, j0, 0ull, 0ull, qpos - 512, qpos, qr, m, l, o, wsf, tid, lane, wave);
        const float lt = l + swap32_other(l);
        att::fold<2>(res, o, lt > 0.f ? g2 / lt : 0.f, wsf, lane, false);
    }
    bf16_t* Y = (bf16_t*)(ws + WS_YN) + (size_t)(b * SEQ + ib * 64 + (wave & 1) * 32 + 4 * hi) * 512 + head * 64 + r32;
    asm volatile("" : "+v"(Y));
#pragma unroll
    for (int r = 0; r < 16; ++r) {
        const int qrow = (r & 3) + 8 * (r >> 2);
#pragma unroll
        for (int db = 0; db < 2; ++db) ((__attribute__((address_space(1))) bf16_t*)Y)[(size_t)qrow * 512 + 32 * db] = (bf16_t)(pk_bf16(res[db][r], 0.f) & 0xffffu);
    }
    __syncthreads();
}

__device__ __forceinline__ void cswap_desc(unsigned& a, unsigned& b) { const unsigned hi = a > b ? a : b, lo = a > b ? b : a; a = hi; b = lo; }
__device__ __forceinline__ unsigned f16_order(unsigned hb) { return (hb & 0x8000u) ? (~hb & 0xffffu) : (hb | 0x8000u); }
__device__ __forceinline__ float f16_unorder(unsigned ob) { const unsigned hb = (ob & 0x8000u) ? (ob & 0x7fffu) : (~ob & 0xffffu); return (float)__builtin_bit_cast(_Float16, (unsigned short)hb); }
__device__ __forceinline__ unsigned f32_order(float f) { const unsigned u = __float_as_uint(f); return (u & 0x80000000u) ? ~u : (u | 0x80000000u); }

__device__ __forceinline__ void peer_issue(u32x4 (&uv)[16], float& su, float& sv, const unsigned char* UVb, const float* TSC, const LAS unsigned* tabE, int bt, int myslot, unsigned lane16) {
#pragma unroll
    for (int e = 0; e < 16; ++e) { const unsigned off = tabE[bt * 16 + e] + lane16; uv[e] = *(const u32x4*)(UVb + off); }
    const unsigned myidx = tabE[bt * 16 + myslot] >> 10;
    su = TSC[myidx]; sv = TSC[NEXP + myidx];
}
__device__ __forceinline__ float peer_dot(const u32x4 (&uv)[16], float su, float sv, const int (&cH)[2], const int (&cL)[2], float chalf, float rsc, const LAS float* tabG, int bt, int myslot, int lane) {
    float part[16];
#pragma unroll
    for (int e = 0; e < 16; ++e) {
        int ah = __builtin_amdgcn_sdot8((int)uv[e][0], cH[0], 0, false); ah = __builtin_amdgcn_sdot8((int)uv[e][1], cH[1], ah, false);
        int al = __builtin_amdgcn_sdot8((int)uv[e][0], cL[0], 0, false); al = __builtin_amdgcn_sdot8((int)uv[e][1], cL[1], al, false);
        part[e] = (float)(ah * 16 + al);
    }
    float r8[8];
#pragma unroll
    for (int e = 0; e < 8; ++e) {
        auto rr = __builtin_amdgcn_permlane32_swap(__float_as_uint(part[e]), __float_as_uint(part[e + 8]), false, false);
        r8[e] = __uint_as_float(rr[0]) + __uint_as_float(rr[1]);
    }
    const bool b4 = (lane & 16) != 0, b3 = (lane & 8) != 0, b2 = (lane & 4) != 0;
    float r4[4];
#pragma unroll
    for (int e = 0; e < 4; ++e) { const float send = b4 ? r8[e] : r8[e + 4], keep = b4 ? r8[e + 4] : r8[e]; r4[e] = keep + swz16f(send); }
    float r2[2];
#pragma unroll
    for (int e = 0; e < 2; ++e) { const float send = b3 ? r4[e] : r4[e + 2], keep = b3 ? r4[e + 2] : r4[e]; r2[e] = keep + dppf<DPP_ROR8>(send); }
    float r1;
    { const float send = b2 ? r2[0] : r2[1], keep = b2 ? r2[1] : r2[0]; r1 = keep + dppf<DPP_HMIRROR>(send); }
    r1 += dppf<DPP_XOR1>(r1); r1 += dppf<DPP_XOR2>(r1);
    return gelu_poly((r1 + chalf) * rsc * su) * tabG[bt * 16 + myslot] * sv;
}
__device__ __forceinline__ void peer_vphase(const u32x4 (&uv)[16], float hval, f32x4 (&acc)[4]) {
#pragma unroll
    for (int e = 0; e < 16; ++e) {
        const float w = __int_as_float(__builtin_amdgcn_readlane(__float_as_int(hval), e * 4));
        const f32x2 w2 = {w, w};
#pragma unroll
        for (int h = 0; h < 2; ++h) {
            const f32x2 p0 = __builtin_amdgcn_cvt_scalef32_pk_f32_fp4(uv[e][2 + h], 1.0f, 0), p1 = __builtin_amdgcn_cvt_scalef32_pk_f32_fp4(uv[e][2 + h], 1.0f, 1);
            const f32x2 p2 = __builtin_amdgcn_cvt_scalef32_pk_f32_fp4(uv[e][2 + h], 1.0f, 2), p3 = __builtin_amdgcn_cvt_scalef32_pk_f32_fp4(uv[e][2 + h], 1.0f, 3);
            f32x2 a0 = {acc[2 * h][0], acc[2 * h][1]}, a1 = {acc[2 * h][2], acc[2 * h][3]}, a2 = {acc[2 * h + 1][0], acc[2 * h + 1][1]}, a3 = {acc[2 * h + 1][2], acc[2 * h + 1][3]};
            a0 += w2 * p0; a1 += w2 * p1; a2 += w2 * p2; a3 += w2 * p3;
            acc[2 * h] = (f32x4){a0.x, a0.y, a1.x, a1.y}; acc[2 * h + 1] = (f32x4){a2.x, a2.y, a3.x, a3.y};
        }
    }
}
__device__ __forceinline__ void peer_retrieve_chunk(const unsigned short* SC, LAS unsigned* tabE, LAS float* tabG, int g, int lane) {
    const int row = lane >> 4, j = lane & 15;
    {
        const u32x4 raw = *(const u32x4*)(SC + g * 512 + lane * 8);
        unsigned k[8];
#pragma unroll
        for (int e = 0; e < 4; ++e) {
            const unsigned w = raw[e];
            k[2 * e] = (f16_order(w & 0xffffu) << 16) | (unsigned)(127 - (8 * j + 2 * e));
            k[2 * e + 1] = (f16_order(w >> 16) << 16) | (unsigned)(127 - (8 * j + 2 * e + 1));
        }
        cswap_desc(k[0], k[1]); cswap_desc(k[2], k[3]); cswap_desc(k[4], k[5]); cswap_desc(k[6], k[7]);
        cswap_desc(k[0], k[2]); cswap_desc(k[1], k[3]); cswap_desc(k[4], k[6]); cswap_desc(k[5], k[7]);
        cswap_desc(k[1], k[2]); cswap_desc(k[5], k[6]); cswap_desc(k[0], k[4]); cswap_desc(k[3], k[7]);
        cswap_desc(k[1], k[5]); cswap_desc(k[2], k[6]);
        cswap_desc(k[1], k[4]); cswap_desc(k[3], k[6]);
        cswap_desc(k[2], k[4]); cswap_desc(k[3], k[5]);
        cswap_desc(k[3], k[4]);
        unsigned mine = 0u;
#pragma unroll
        for (int it = 0; it < 16; ++it) {
            const unsigned w = row16_maxu(k[0]);
            if (k[0] == w) { k[0] = k[1]; k[1] = k[2]; k[2] = k[3]; k[3] = k[4]; k[4] = k[5]; k[5] = k[6]; k[6] = k[7]; k[7] = 0u; }
            mine = (j == it) ? w : mine;
        }
        const int hl = row >> 1, c = row & 1;
        static constexpr unsigned PTAB[32] = {0x31000u, 0x33020u, 0x35040u, 0x37060u, 0x39080u, 0x3b0a0u, 0x3d0c0u, 0x3f0e0u, 0x31101u, 0x33121u, 0x35141u, 0x37161u, 0x31202u, 0x33222u, 0x20042u, 0x31303u, 0x33323u, 0x31404u, 0x20024u, 0x31505u, 0x31606u, 0x31707u, 0x30908u, 0x30b0au, 0x30d0cu, 0x30f0eu, 0x00000u, 0x00000u, 0x00000u, 0x00000u, 0x00000u, 0x00000u};
        const unsigned te = PTAB[(row & 1) * 16 + j];
        const int a0 = te & 15, b0 = (te >> 4) & 15, a1 = (te >> 8) & 15, b1 = (te >> 12) & 15;
        const int base1 = (2 * hl) * 16, base2 = (2 * hl + 1) * 16;
        const unsigned k1a = (unsigned)__shfl((int)mine, base1 + a0), k2a = (unsigned)__shfl((int)mine, base2 + b0);
        const unsigned k1b = (unsigned)__shfl((int)mine, base1 + a1), k2b = (unsigned)__shfl((int)mine, base2 + b1);
        const float s0 = f16_unorder(k1a >> 16) + f16_unorder(k2a >> 16), s1 = f16_unorder(k1b >> 16) + f16_unorder(k2b >> 16);
        unsigned ck0 = ((te >> 17) & 1u) ? ((f32_order(s0) & 0xffffff00u) | (unsigned)(255 - (a0 * 16 + b0))) : 0u;
        unsigned ck1 = ((te >> 16) & 1u) ? ((f32_order(s1) & 0xffffff00u) | (unsigned)(255 - (a1 * 16 + b1))) : 0u;
        unsigned mine2 = 0u;
#pragma unroll
        for (int it = 0; it < 16; ++it) {
            unsigned w = row16_maxu(ck0);
            const unsigned w2 = swz16u(w); w = w > w2 ? w : w2;
            if (ck0 == w) { ck0 = ck1; ck1 = 0u; }
            mine2 = (j == it) ? w : mine2;
        }
        const int flat = 255 - (int)(mine2 & 0xffu), a = flat >> 4, bb = flat & 15;
        const unsigned ka = (unsigned)__shfl((int)mine, (2 * hl) * 16 + a), kb = (unsigned)__shfl((int)mine, (2 * hl + 1) * 16 + bb);
        const float sc = f16_unorder(ka >> 16) + f16_unorder(kb >> 16);
        const int i1 = 127 - (int)(ka & 0xffffu), i2 = 127 - (int)(kb & 0xffffu);
        const float smax = __shfl(sc, (lane & 48));
        const float ex = __expf(sc - smax);
        const float den = row16_sum(ex);
        if (c == 0) { const int slot = (2 * g + hl) * 16 + j; tabE[slot] = (unsigned)(i1 * 128 + i2) << 10; tabG[slot] = ex * __builtin_amdgcn_rcpf(den); }
    }
}
__device__ __forceinline__ void peer_phase(const Params& P, LAS unsigned char* lds, int gw, int NGW, int wave, int lane, bool alt) {
    unsigned char* ws = P.ws;
    LAS unsigned* tabs = (LAS unsigned*)(lds + wave * 16384);
    const int ntok = (NT - gw + NGW - 1) / NGW;
#if ENABLE_PEER
#pragma nounroll
    for (int g = 0; g < 4; ++g) peer_retrieve_chunk((const unsigned short*)(ws + WS_SC) + (size_t)gw * 2048, tabs, (LAS float*)(tabs + 128), g, lane);
    const unsigned char* UVb = (const unsigned char*)(ws + WS_UT);
    const float* TSC = (const float*)(ws + WS_TSC);
    const int myslot = (lane >> 2) & 15;
#endif
#pragma nounroll
    for (int k0 = 0; k0 < (ntok < 16 ? ntok : 16) * (PROBE_P7 == 2 ? 2 : 1); ++k0) {
        const int k = k0 & 15;
        const bool dummy = alt;
        const int t = gw + k * NGW;
        float* hrow = P.out + (size_t)t * DM;
        f32x4 acc[4];
#pragma unroll
        for (int i = 0; i < 4; ++i) acc[i] = (f32x4){0.f, 0.f, 0.f, 0.f};
        float hres[16];
        { const bf16_t* HBr = (const bf16_t*)(ws + WS_HG) + (size_t)t * DM; const u32x4 ca = *(const u32x4*)(HBr + lane * 16), cb = *(const u32x4*)(HBr + lane * 16 + 8);
#pragma unroll
          for (int i = 0; i < 4; ++i) { hres[2 * i] = bf_lo(ca[i]); hres[2 * i + 1] = bf_hi(ca[i]); hres[8 + 2 * i] = bf_lo(cb[i]); hres[8 + 2 * i + 1] = bf_hi(cb[i]); } }
#if ENABLE_PEER
        const LAS unsigned* tabE = tabs + k * 256; const LAS float* tabG = (const LAS float*)(tabE + 128);
        const float rs = rsqrtf(((const float*)(ws + WS_SS))[t] * (1.0f / DM) + RMS_EPS);
        int cH[2], cL[2]; float chalf, rsc;
        {
            float am = 0.f;
#pragma unroll
            for (int i = 0; i < 16; ++i) am = fmaxf(am, fabsf(hres[i]));
            am = wave_max(am);
            const float s_c = am * (1.0f / 119.0f) + 1e-30f, inv_c = 1.0f / s_c;
            int csum = 0;
#pragma unroll
            for (int h2 = 0; h2 < 2; ++h2) {
                unsigned wh = 0u, wl = 0u;
#pragma unroll
                for (int i = 0; i < 8; ++i) {
                    const int C = (int)rintf(hres[8 * h2 + i] * inv_c);
                    const int H = (C + 8) >> 4, L = C - 16 * H;
                    wh |= ((unsigned)H & 15u) << (4 * i); wl |= ((unsigned)L & 15u) << (4 * i);
                    csum += C;
                }
                cH[h2] = (int)wh; cL[h2] = (int)wl;
            }
            chalf = 0.5f * wave_sum((float)csum);
            rsc = rs * s_c;
        }
#pragma nounroll
        for (int bt = 0; bt < 8; ++bt) {
            u32x4 uv[16]; float su, sv;
            peer_issue(uv, su, sv, UVb, TSC, tabE, bt, myslot, (unsigned)lane * 16u);
            if (!(bt & 1) && k0 + 1 < (ntok < 16 ? ntok : 16))
                peer_retrieve_chunk((const unsigned short*)(ws + WS_SC) + (size_t)(t + NGW) * 2048, tabs + (k + 1) * 256, (LAS float*)(tabs + (k + 1) * 256 + 128), bt >> 1, lane);
            const float hval = peer_dot(uv, su, sv, cH, cL, chalf, rsc, tabG, bt, myslot, lane);
            peer_vphase(uv, hval, acc);
        }
#endif
        const float* fn = P.in[23];
        f32x4 y[4];
#pragma unroll
        for (int i = 0; i < 4; ++i) y[i] = (f32x4){hres[4 * i], hres[4 * i + 1], hres[4 * i + 2], hres[4 * i + 3]} + acc[i];
        float s = 0.f;
#pragma unroll
        for (int i = 0; i < 4; ++i) s += (y[i][0] * y[i][0] + y[i][1] * y[i][1]) + (y[i][2] * y[i][2] + y[i][3] * y[i][3]);
        const float rsf = rsqrtf(wave_sum(s) * (1.0f / DM) + RMS_EPS);
        float* orow = dummy ? (float*)(ws + 96 * MiB) + (size_t)t * 512 - lane * 0 : hrow;
        if (!dummy || lane < 32) {
#pragma unroll
            for (int i = 0; i < 4; ++i) *(f32x4*)(orow + lane * 16 + 4 * i) = y[i] * rsf * *(const f32x4*)(fn + lane * 16 + 4 * i);
        }
    }
}

typedef __attribute__((address_space(1))) unsigned gu32;
#define XB_TMO      128
#define XB_XCNT(j)  (256  + 64 * (j))
#define XB_XSUB(j)  (1280 + 64 * (j))
#define XB_XGEN(j)  (2304 + 64 * (j))
#define XB_TOP      3328
#define XB_TOPGEN   3392
#define XCD_BAR_WORDS 3456
#define XB_SPIN_CAP (1u << 18)

__device__ __forceinline__ unsigned xb_ld(unsigned* p)              { return __hip_atomic_load(p, __ATOMIC_RELAXED, __HIP_MEMORY_SCOPE_AGENT); }
__device__ __forceinline__ unsigned xb_add(unsigned* p, unsigned v) { return __hip_atomic_fetch_add(p, v, __ATOMIC_RELAXED, __HIP_MEMORY_SCOPE_AGENT); }
__device__ __forceinline__ unsigned xb_xcc_id() { return (unsigned)__builtin_amdgcn_s_getreg((3 << 11) | 20) & 0xFu; }
#define XB_SPIN(cond, bar) do { unsigned _sp = 0; while (cond) { __builtin_amdgcn_s_sleep(1); \
    if ((++_sp & 255u) == 0u) { if (xb_ld(&(bar)[XB_TMO])) break; if (_sp > XB_SPIN_CAP) { atomicAdd(&(bar)[XB_TMO], 1u); break; } } } } while (0)

struct XcdBarrier {
    unsigned* bar; unsigned x;
    volatile LAS unsigned* st;
};

__device__ __forceinline__ XcdBarrier xcd_barrier_post(unsigned* bar, volatile LAS unsigned* st) {
    XcdBarrier b; b.bar = bar; b.x = xb_xcc_id(); b.st = st;
    if (threadIdx.x == 0) (void)xb_add(&bar[XB_XCNT(b.x)], 1u);
    return b;
}
__device__ __forceinline__ void xcd_barrier_complete(unsigned* bar, unsigned x, unsigned& nloc, unsigned& nx) {
    const unsigned G = gridDim.x * gridDim.y * gridDim.z;
    unsigned sum, cnt, mine, sp = 0u;
    for (;;) {
        sum = 0u; cnt = 0u; mine = 0u;
#pragma unroll
        for (unsigned j = 0; j < 16; ++j) { const unsigned c = xb_ld(&bar[XB_XCNT(j)]); sum += c; cnt += (c > 0u) ? 1u : 0u; mine = (j == x) ? c : mine; }
        if (sum == G) break;
        __builtin_amdgcn_s_sleep(1);
        if ((++sp & 255u) == 0u) { if (xb_ld(&bar[XB_TMO])) break; if (sp > XB_SPIN_CAP) { atomicAdd(&bar[XB_TMO], 1u); break; } }
    }
    nloc = mine > 0u ? mine : 1u; nx = cnt > 0u ? cnt : 1u;
}

__device__ __forceinline__ void xcd_barrier(const XcdBarrier& b) {
    asm volatile("s_waitcnt vmcnt(0)" ::: "memory");
    __syncthreads();
    if (threadIdx.x == 0) {
        unsigned* bar = b.bar;
        __builtin_amdgcn_s_waitcnt(0);
        unsigned nloc = b.st[0], nx = b.st[1];
        if (nloc == 0u) { xcd_barrier_complete(bar, b.x, nloc, nx); b.st[0] = nloc; b.st[1] = nx; }
        const unsigned old = xb_add(&bar[XB_XSUB(b.x)], 1u);
        const unsigned gen = old / nloc;
        if (old + 1u == (gen + 1u) * nloc) {
            __builtin_amdgcn_fence(__ATOMIC_RELEASE, "agent");
            asm volatile("s_waitcnt vmcnt(0)" ::: "memory");
            const unsigned og = xb_add(&bar[XB_TOP], 1u);
            const unsigned tg = og / nx;
            if (og + 1u == (tg + 1u) * nx) xb_add(&bar[XB_TOPGEN], 1u);
            else XB_SPIN(xb_ld(&bar[XB_TOPGEN]) == tg, bar);
            __builtin_amdgcn_fence(__ATOMIC_ACQUIRE, "agent");
            xb_add(&bar[XB_XGEN(b.x)], 1u);
            asm volatile("s_waitcnt vmcnt(0)" ::: "memory");
        } else {
            XB_SPIN(xb_ld(&bar[XB_XGEN(b.x)]) == gen, bar);
            __builtin_amdgcn_fence(__ATOMIC_ACQUIRE, "agent");
            asm volatile("s_waitcnt vmcnt(0)" ::: "memory");
        }
    }
    __syncthreads();
}

__global__ void __launch_bounds__(NWAVES * 64, 2) mega_fwd(Params P) {
    extern __shared__ __attribute__((aligned(16))) unsigned char lds_raw[];
    LAS unsigned char* lds = (LAS unsigned char*)lds_raw;
    const int tid = threadIdx.x, lane = tid & 63, wave = __builtin_amdgcn_readfirstlane(tid >> 6);
    const int G = gridDim.x, bx = blockIdx.x;
    const int vcu = (G % 8 == 0) ? (bx % 8) * (G / 8) + bx / 8 : bx;
    const int gw = vcu * NWAVES + wave, NGW = G * NWAVES;
    unsigned char* ws = P.ws;
    const int lo = P.ph_lo, hi = P.ph_hi;
#ifndef PH_MASK
#define PH_MASK 0xff
#endif
#define IN_PH(k) (((PH_MASK >> (k)) & 1) && lo <= (k) && (k) < hi)
    volatile LAS unsigned* bst = (volatile LAS unsigned*)(lds + LDS_BYTES - 64);
    if (tid < 2) bst[tid] = 0u;
    __syncthreads();
    XcdBarrier xbar = xcd_barrier_post((unsigned*)(ws + WS_BAR), bst);
#if USE_XCD_BARRIER
#define SEAM(k) do { if (IN_PH(k) && IN_PH((k) + 1)) { xcd_barrier(xbar); } } while (0)
    if (P.ph_lo < 0) cg::this_grid().sync();
#else
#define SEAM(k) do { if (IN_PH(k) && IN_PH((k) + 1)) { cg::this_grid().sync(); } } while (0)
#endif

    if (IN_PH(0)) { p0_prep(P, lds, gw, NGW, wave, lane, 0); xcd_barrier(xbar); p0_prep(P, lds, gw, NGW, wave, lane, 1); }
    SEAM(0);
    if (IN_PH(1)) {
        pg8::Gemm g{(const bf16_t*)(ws + WS_A), (const bf16_t*)(ws + WS_WIN_T), NT, NPAD, DM / 2};
        pg8::StaticOrder S; S.init(NT, NPAD, G, bx);
        EpiInProj E{(bf16_t*)(ws + WS_ZA), (bf16_t*)(ws + WS_GM), (float*)(ws + WS_GN), (const float*)(ws + WS_ROPE), P.alt, (const float*)(ws + WS_ASC), (const float*)(ws + WS_WSC)};
        pg8::gemm_phase<EpiInProj, pg8::StaticOrder, true, true, true>(lds, g, S, E);
    }
    SEAM(1);
    if (IN_PH(2)) {
        for (int w = vcu; w < 256; w += G) compress_tasks(P, lds, w, wave, lane);
        for (int w0 = vcu; w0 < 256 * (1 + ((REPEAT_PH >> 2) & 1)); w0 += G) {
            const int w = w0 & 255;
            const int bh = w >> 3, s = w & 7;
#pragma nounroll
            for (int u = 0; u < 2; ++u) da_unit(P, lds, bh >> 2, bh & 3, u == 0 ? 15 - s : s, tid, lane, wave);
        }
    }
    SEAM(2);
    if (IN_PH(3)) {
#if ENABLE_NSA
        for (int w0 = vcu; w0 < 256 * (1 + ((REPEAT_PH >> 3) & 1)); w0 += G) {
            const int w = w0 & 255;
            const int bg = w >> 4, s = w & 15;
#pragma nounroll
            for (int u = 0; u < 4; ++u) nsa_unit(P, lds, bg >> 1, bg & 1, u == 0 ? 63 - s : (u == 1 ? 47 - s : (u == 2 ? 16 + s : s)), tid, lane, wave);
        }
#else
        { u32x4* z = (u32x4*)(ws + WS_YN); const size_t n16 = (size_t)NT * 512 * 2 / 16;
          for (size_t i = (size_t)gw * 64 + lane; i < n16; i += (size_t)NGW * 64) z[i] = (u32x4){0u, 0u, 0u, 0u}; }
#endif
    }
    SEAM(3);
    if (IN_PH(4)) {
        {
            pg8::Gemm g{(const bf16_t*)(ws + WS_YDA), (const bf16_t*)(ws + WS_PDA_T), NT, DM, 512};
            pg8::StaticOrder S; S.init(NT, DM, G, bx);
            EpiGate<0> E{(const bf16_t*)(ws + WS_GM), (bf16_t*)(ws + WS_TMP), (bf16_t*)(ws + WS_TMP)};
            pg8::gemm_phase<EpiGate<0>, pg8::StaticOrder, true, true>(lds, g, S, E);
        }
        asm volatile("s_waitcnt vmcnt(0)" ::: "memory"); __syncthreads();
        {
            pg8::Gemm g{(const bf16_t*)(ws + WS_YN), (const bf16_t*)(ws + WS_PNSA_T), NT, DM, 512};
            pg8::StaticOrder S; S.init(NT, DM, G, bx);
            EpiGate<1> E{(const bf16_t*)(ws + WS_GM), (bf16_t*)(ws + WS_TMP), (bf16_t*)(ws + WS_MERGED)};
            pg8::gemm_phase<EpiGate<1>, pg8::StaticOrder, true, true>(lds, g, S, E);
        }
    }
    SEAM(4);
    if (IN_PH(5)) {
        pg8::Gemm g{(const bf16_t*)(ws + WS_MERGED), (const bf16_t*)(ws + WS_WO_T), NT, DM, DM};
        pg8::StaticOrder S; S.init(NT, DM, G, bx);
        EpiWo E{P.in[0], (bf16_t*)(ws + WS_HG), (float*)(ws + (P.alt ? WS_SS + 512 * 1024 : WS_SS))};
        pg8::gemm_phase<EpiWo, pg8::StaticOrder, true, true>(lds, g, S, E);
    }
    SEAM(5);
    if (IN_PH(6)) {
#if ENABLE_PEER
        pg8::Gemm g{(const bf16_t*)(ws + WS_HG), (const bf16_t*)(ws + WS_WP_T), NT, 2048, DM};
        TableOrder S; S.init(NT, 2048, G, bx); S.P = &P; S.gw = gw; S.calls = 0;
        EpiScores E{(const float*)(ws + WS_SS), (unsigned short*)(ws + WS_SC)};
        pg8::gemm_phase<EpiScores, TableOrder, true, true>(lds, g, S, E);
        for (int c = S.calls; c < 4; ++c) convert_table_rows<4>(P, (gw * 4 + c) * 4, lane);
#endif
    }
    SEAM(6);
    if (IN_PH(7)) {
        peer_phase(P, lds, gw, NGW, wave, lane, P.alt != 0);
    }
#if UBENCH
    {
        unsigned x[8]; f32x2 a[8];
#pragma unroll
        for (int i = 0; i < 8; ++i) { x[i] = (unsigned)(tid * 2654435761u + i * 40503u); a[i] = (f32x2){(float)i, 1.0f}; }
#pragma nounroll
        for (int it = 0; it < 4096; ++it) {
#pragma unroll
            for (int i = 0; i < 8; ++i) {
#if UBENCH == 1
                const f32x2 p = __builtin_amdgcn_cvt_scalef32_pk_f32_fp4(x[i], 1.0f, 0), q = __builtin_amdgcn_cvt_scalef32_pk_f32_fp4(x[i], 1.0f, 1);
                x[i] = x[i] * 5u + __float_as_uint(p.x + q.y);
#elif UBENCH == 2
                a[i] = a[i] * (f32x2){1.0001f, 0.9999f} + (f32x2){0.5f, 0.25f}; a[i] = a[i] * (f32x2){0.9999f, 1.0001f} + (f32x2){0.25f, 0.5f};
#elif UBENCH == 3
                const f32x2 p = __builtin_amdgcn_cvt_pk_f32_fp8((int)x[i], false), q = __builtin_amdgcn_cvt_pk_f32_fp8((int)x[i], true);
                x[i] = x[i] * 5u + __float_as_uint(p.x + q.y);
#elif UBENCH == 5
                x[i] = x[i] * 5u + __float_as_uint(__builtin_amdgcn_exp2f(__uint_as_float(x[i] & 0xbfffffffu)) + __builtin_amdgcn_exp2f(__uint_as_float((x[i] >> 1) & 0xbfffffffu)));
#elif UBENCH == 6
                x[i] = (unsigned)__builtin_amdgcn_sdot8((int)x[i], (int)(x[i] >> 3), (int)x[i], false); x[i] = (unsigned)__builtin_amdgcn_sdot8((int)x[i], 0x12345678, (int)x[i], false);
#elif UBENCH == 4
                x[i] = x[i] * 5u + __float_as_uint(__uint_as_float(x[i]) + 1.0f);
#endif
            }
        }
        unsigned r = 0; float fs = 0.f;
#pragma unroll
        for (int i = 0; i < 8; ++i) { r ^= x[i]; fs += a[i].x + a[i].y; }
        if ((r ^ __float_as_uint(fs)) == 0x12345678u) ((unsigned*)(ws + WS_MISC))[1000 + (tid & 7)] = r;
    }
#endif
#undef IN_PH
#undef SEAM
}

extern "C" void kernel_launch(void* const* d_in, const int* in_sizes, int n_in, void* d_out, int out_size, void* d_ws, size_t ws_size, hipStream_t stream) {
    static int grid = 0;
    if (grid == 0) {
        if (n_in != 24 || in_sizes[0] != NT * DM || out_size != NT * DM || ws_size < WS_END) {
            fprintf(stderr, "kernel_launch: unexpected shapes (n_in %d, in0 %d, out %d, ws %zu); nothing launched\n", n_in, n_in > 0 ? in_sizes[0] : -1, out_size, ws_size); grid = -1; return; }
        int dev = 0, cus = 0, per_cu = 0;
        hipGetDevice(&dev); hipDeviceGetAttribute(&cus, hipDeviceAttributeMultiprocessorCount, dev);
        if (hipFuncSetAttribute((const void*)mega_fwd, hipFuncAttributeMaxDynamicSharedMemorySize, LDS_BYTES) != hipSuccess) { fprintf(stderr, "kernel_launch: hipFuncSetAttribute failed\n"); grid = -1; return; }
        if (hipOccupancyMaxActiveBlocksPerMultiprocessor(&per_cu, (const void*)mega_fwd, NWAVES * 64, LDS_BYTES) != hipSuccess || per_cu < 1) { fprintf(stderr, "kernel_launch: occupancy query says %d\n", per_cu); per_cu = 1; }
        (void)hipGetLastError();
        grid = cus;
        if (grid > 256) grid = 256;
    }
    if (grid < 0) return;
    if (hipMemsetAsync((char*)d_ws + WS_BAR, 0, 131072, stream) != hipSuccess) { fprintf(stderr, "kernel_launch: hipMemsetAsync failed\n"); return; }
    Params p{};
    for (int i = 0; i < 24; ++i) p.in[i] = (const float*)d_in[i];
    p.out = (float*)d_out; p.ws = (unsigned char*)d_ws;
#if N_LAUNCH_MODE == 1
    p.ph_lo = 0; p.ph_hi = 8; p.alt = 0;
    void* args[] = {&p};
    hipError_t e = hipLaunchCooperativeKernel((const void*)mega_fwd, dim3(grid), dim3(NWAVES * 64), args, LDS_BYTES, stream);
    if (e != hipSuccess) fprintf(stderr, "kernel_launch: cooperative launch failed: %s (grid %d)\n", hipGetErrorString(e), grid);
#else
    for (int ph = 0; ph < 8; ++ph) {
        p.ph_lo = ph; p.ph_hi = ph + 1;
        for (int rep = 0; rep < ((ph == REPEAT_LAUNCH) ? 2 : 1); ++rep) {
            p.alt = (ph == REPEAT_LAUNCH && rep == 0) ? 1 : 0;
            hipLaunchKernelGGL(mega_fwd, dim3(grid), dim3(NWAVES * 64), LDS_BYTES, stream, p);
        }
    }
#endif
}
```

```cpp
#include <hip/hip_runtime.h>
#include <hip/hip_cooperative_groups.h>
#include <hip/hip_bf16.h>
#include <cstdio>
#include <cstdint>
#include <cmath>
namespace cg = cooperative_groups;
namespace pg8 {
#define PG8_LAS __attribute__((address_space(3)))
typedef unsigned short bf16_t;
typedef short bf16x8 __attribute__((ext_vector_type(8)));
typedef float f32x4 __attribute__((ext_vector_type(4)));
typedef unsigned u32x4 __attribute__((ext_vector_type(4)));
constexpr int BM = 256, BK = 64, HALF = 128, HTB = HALF * BK * 2  , STAGE_BYTES = 8 * HTB, NXCD = 8, WGM = 8;

__host__ __device__ __forceinline__ int lds_byte(int r, int c) { const int st = (r >> 4) * 2 + (c >> 5), rr = r & 15, cc = c & 31, ob = rr * 64 + cc * 2; return st * 1024 + (ob ^ (((ob >> 9) & 1) << 5)); }
__host__ __device__ __forceinline__ void stage_rc(int b, int& R, int& C) { const int st = b / 1024, sb = b % 1024, swz = sb ^ (((sb >> 9) & 1) << 5); R = (st >> 1) * 16 + swz / 64; C = (st & 1) * 32 + (swz % 64) / 2; }
__host__ __device__ __forceinline__ int perm32(int rho) { const int n = rho >> 4, i = rho & 15; return 8 * (i >> 2) + 4 * n + (i & 3); }

struct Unit { int pm, pn; };
struct Gemm { const bf16_t* A; const bf16_t* Bt; int M, N, K; };

struct StaticOrder {
    int nM, nN, nwg, G, c;
    __host__ __device__ void init(int M, int N, int G_, int c_) { nM = M / BM; nN = N / BM; nwg = nM * nN; G = G_; c = c_; }
    __host__ __device__ bool next(int i, Unit& u) const {
        const long L = (long)i * G + c; if (L >= nwg) return false;
        int wgid = (int)L; { const int q = nwg / NXCD, r = nwg % NXCD, xcd = wgid % NXCD, off = wgid / NXCD; wgid = (xcd < r ? xcd * (q + 1) : r * (q + 1) + (xcd - r) * q) + off; }
        const int nig = WGM * nN, gid = wgid / nig, fm = gid * WGM, gsz = (nM - fm) < WGM ? (nM - fm) : WGM;
        u.pm = fm + ((wgid % nig) % gsz); u.pn = (wgid % nig) / gsz; return true;
    }
    __device__ __forceinline__ void a_ready(const Unit&) const {}
    __device__ __forceinline__ void done(const Unit&) const {}
};

__device__ __forceinline__ unsigned cvt_pk_bf16(float lo, float hi) { unsigned r; asm volatile("v_cvt_pk_bf16_f32 %0, %1, %2" : "=v"(r) : "v"(lo), "v"(hi)); return r; }
typedef float f32x2 __attribute__((ext_vector_type(2)));
typedef int i32x4 __attribute__((ext_vector_type(4)));
template <class Epi, class Sched, bool ALIGN_EPI = false, bool SP2 = false, bool I8 = false>
__device__ __forceinline__ void gemm_phase(PG8_LAS unsigned char* lds, const Gemm g, const Sched& S, const Epi& E) {
    const int tid = threadIdx.x, wid = __builtin_amdgcn_readfirstlane(tid >> 6), lane = tid & 63, wr = wid >> 2, wc = wid & 3, fr = lane & 15, fq = lane >> 4;
    const int K = g.K, nt = K / BK;
    unsigned voffA[2], voffB[2];
#pragma unroll
    for (int i = 0; i < 2; ++i) { int R, C; stage_rc(tid * 16 + i * 8192, R, C); const int Rb = Epi::PERM ? ((R & ~31) + perm32(R & 31)) : R;
        voffA[i] = (unsigned)(R * K + C) * 2u; voffB[i] = (unsigned)(Rb * K + C) * 2u; }
    const size_t kstep = (size_t)(BK * 2);
    const size_t hstep = (size_t)HALF * K * 2;
    const size_t tstep = 2 * hstep;
    const unsigned ldsw = (unsigned)wid * 1024u;
    const int aoff = lds_byte(wr * 64 + fr, fq * 8), boff = lds_byte(wc * 32 + fr, fq * 8);
#define PG8_SA(b, h) (((b) * 2 + (h)) * HTB)
#define PG8_SB(b, h) ((4 + (b) * 2 + (h)) * HTB)
#define PG8_STAGE(bufoff, gbase, voff) do { _Pragma("unroll") for (int _i = 0; _i < 2; ++_i) \
        __builtin_amdgcn_global_load_lds((const unsigned*)((const char*)(gbase) + (voff)[_i]), (PG8_LAS unsigned*)(lds + (bufoff) + ldsw + _i * 8192), 16, 0, 0); } while (0)
#define PG8_LDA(dst, b, h) do { _Pragma("unroll") for (int m = 0; m < 4; ++m) _Pragma("unroll") for (int k = 0; k < 2; ++k) dst[m][k] = *(const PG8_LAS bf16x8*)(lds + PG8_SA(b, h) + aoff + m * 2048 + k * 1024); } while (0)
#define PG8_LDB(dst, b, h) do { _Pragma("unroll") for (int n = 0; n < 2; ++n) _Pragma("unroll") for (int k = 0; k < 2; ++k) dst[n][k] = *(const PG8_LAS bf16x8*)(lds + PG8_SB(b, h) + boff + n * 2048 + k * 1024); } while (0)
#define PG8_MMA(ai, bj, At, Bt) do { __builtin_amdgcn_s_setprio(1); _Pragma("unroll") for (int m = 0; m < 4; ++m) _Pragma("unroll") for (int n = 0; n < 2; ++n) _Pragma("unroll") for (int k = 0; k < 2; ++k) { \
        if constexpr (I8) acc[ai][bj][m][n] = __builtin_bit_cast(f32x4, __builtin_amdgcn_mfma_i32_16x16x64_i8(__builtin_bit_cast(i32x4, Bt[n][k]), __builtin_bit_cast(i32x4, At[m][k]), __builtin_bit_cast(i32x4, acc[ai][bj][m][n]), 0, 0, 0)); \
        else acc[ai][bj][m][n] = __builtin_amdgcn_mfma_f32_16x16x32_bf16(Bt[n][k], At[m][k], acc[ai][bj][m][n], 0, 0, 0); } __builtin_amdgcn_s_setprio(0); } while (0)
#define PG8_WAIT_V(n) asm volatile("s_waitcnt vmcnt(" #n ")" ::: "memory")
#define PG8_WAIT_L(n) asm volatile("s_waitcnt lgkmcnt(" #n ")" ::: "memory")
#define PG8_BAR __builtin_amdgcn_s_barrier()
#define PG8_SCHED __builtin_amdgcn_sched_barrier(0)
    Unit cur, nxt; int ui = 0;
    if (!S.next(0, cur)) return;
    f32x4 acc[2][2][4][2];
#pragma unroll
    for (int a = 0; a < 2; ++a)
#pragma unroll
        for (int b = 0; b < 2; ++b)
#pragma unroll
            for (int m = 0; m < 4; ++m)
#pragma unroll
                for (int n = 0; n < 2; ++n) acc[a][b][m][n] = (f32x4){0.f, 0.f, 0.f, 0.f};
    bf16x8 At[4][2], B0[2][2], B1[2][2];
    const char* cA = (const char*)g.A + (size_t)cur.pm * tstep; const char* cB = (const char*)g.Bt + (size_t)cur.pn * tstep;
    S.a_ready(cur);
    if constexpr (SP2) {
        PG8_STAGE(PG8_SB(0, 0), cB, voffB); PG8_STAGE(PG8_SB(0, 1), cB + hstep, voffB); PG8_STAGE(PG8_SA(0, 0), cA, voffA); PG8_STAGE(PG8_SA(0, 1), cA + hstep, voffA);
        if (wr == 1) PG8_BAR;
        PG8_WAIT_V(2); PG8_BAR;
        PG8_STAGE(PG8_SB(1, 0), cB + kstep, voffB); PG8_STAGE(PG8_SA(1, 0), cA + kstep, voffA); PG8_STAGE(PG8_SB(1, 1), cB + hstep + kstep, voffB);
        PG8_WAIT_V(6); PG8_BAR;
    } else {
        PG8_STAGE(PG8_SB(0, 0), cB, voffB); PG8_STAGE(PG8_SA(0, 0), cA, voffA); PG8_STAGE(PG8_SB(0, 1), cB + hstep, voffB); PG8_STAGE(PG8_SA(0, 1), cA + hstep, voffA);
        if (wr == 1) PG8_BAR;
        PG8_WAIT_V(4); PG8_BAR;
        PG8_STAGE(PG8_SB(1, 0), cB + kstep, voffB); PG8_STAGE(PG8_SA(1, 0), cA + kstep, voffA); PG8_STAGE(PG8_SB(1, 1), cB + hstep + kstep, voffB);
        PG8_WAIT_V(6); PG8_BAR;
    }
    for (;;) {
        const bool has_next = S.next(ui + 1, nxt);
        const char* nA = has_next ? (const char*)g.A + (size_t)nxt.pm * tstep : cA; const char* nB = has_next ? (const char*)g.Bt + (size_t)nxt.pn * tstep : cB;
        for (int t = 0; t < nt; t += 2) {
            const bool last = (t == nt - 2);
            if constexpr (Epi::MIDK) { if (t == nt / 2) { int t_ = (int)threadIdx.x; asm volatile("" : "+v"(t_)); E.mid(acc, cur, wr, wc, t_ & 15, (t_ >> 4) & 3); } }
            const char* a1 = cA + (size_t)(t + 1) * kstep;
            const char* a2 = last ? nA : cA + (size_t)(t + 2) * kstep; const char* b2 = last ? nB : cB + (size_t)(t + 2) * kstep;
            const char* a3 = a2 + kstep; const char* b3 = b2 + kstep;
            if (last && has_next) S.a_ready(nxt);
            if constexpr (SP2) {
            PG8_LDB(B0, 0, 0); PG8_LDB(B1, 0, 1); PG8_SCHED; PG8_LDA(At, 0, 0); PG8_STAGE(PG8_SA(1, 1), a1 + hstep, voffA);
            PG8_WAIT_V(8); PG8_WAIT_L(0); PG8_BAR; PG8_MMA(0, 0, At, B0); PG8_MMA(0, 1, At, B1); PG8_BAR; PG8_SCHED;
            PG8_LDA(At, 0, 1); PG8_STAGE(PG8_SB(0, 0), b2, voffB); PG8_STAGE(PG8_SB(0, 1), b2 + hstep, voffB); PG8_STAGE(PG8_SA(0, 0), a2, voffA);
            PG8_WAIT_V(8); PG8_WAIT_L(0); PG8_BAR; PG8_MMA(1, 0, At, B0); PG8_MMA(1, 1, At, B1); PG8_BAR; PG8_SCHED;
            PG8_LDB(B0, 1, 0); PG8_LDB(B1, 1, 1); PG8_SCHED; PG8_LDA(At, 1, 0); PG8_STAGE(PG8_SA(0, 1), a2 + hstep, voffA);
            PG8_WAIT_V(8); PG8_WAIT_L(0); PG8_BAR; PG8_MMA(0, 0, At, B0); PG8_MMA(0, 1, At, B1); PG8_BAR; PG8_SCHED;
            PG8_LDA(At, 1, 1); PG8_STAGE(PG8_SB(1, 0), b3, voffB); PG8_STAGE(PG8_SB(1, 1), b3 + hstep, voffB); PG8_STAGE(PG8_SA(1, 0), a3, voffA);
            PG8_WAIT_V(8); PG8_WAIT_L(0); PG8_BAR; PG8_MMA(1, 0, At, B0); PG8_MMA(1, 1, At, B1); PG8_BAR; PG8_SCHED;
            } else {
            PG8_LDB(B0, 0, 0); PG8_SCHED; PG8_LDA(At, 0, 0); PG8_STAGE(PG8_SA(1, 1), a1 + hstep, voffA);
            PG8_WAIT_L(8); PG8_BAR; PG8_WAIT_L(0); PG8_MMA(0, 0, At, B0); PG8_BAR; PG8_SCHED;
            PG8_LDB(B1, 0, 1); PG8_STAGE(PG8_SB(0, 0), b2, voffB);
            PG8_BAR; PG8_WAIT_L(0); PG8_MMA(0, 1, At, B1); PG8_BAR;
            PG8_LDA(At, 0, 1); PG8_STAGE(PG8_SA(0, 0), a2, voffA);
            PG8_BAR; PG8_WAIT_L(0); PG8_MMA(1, 0, At, B0); PG8_BAR; PG8_SCHED;
            PG8_STAGE(PG8_SB(0, 1), b2 + hstep, voffB);
            PG8_WAIT_V(6); PG8_BAR; PG8_MMA(1, 1, At, B1); PG8_BAR;
            PG8_LDB(B0, 1, 0); PG8_SCHED; PG8_LDA(At, 1, 0); PG8_STAGE(PG8_SA(0, 1), a2 + hstep, voffA);
            PG8_WAIT_L(8); PG8_BAR; PG8_WAIT_L(0); PG8_MMA(0, 0, At, B0); PG8_BAR; PG8_SCHED;
            PG8_LDB(B1, 1, 1); PG8_STAGE(PG8_SB(1, 0), b3, voffB);
            PG8_BAR; PG8_WAIT_L(0); PG8_MMA(0, 1, At, B1); PG8_BAR;
            PG8_LDA(At, 1, 1); PG8_STAGE(PG8_SA(1, 0), a3, voffA);
            PG8_BAR; PG8_WAIT_L(0); PG8_MMA(1, 0, At, B0); PG8_BAR; PG8_SCHED;
            PG8_STAGE(PG8_SB(1, 1), b3 + hstep, voffB);
            PG8_WAIT_V(6); PG8_BAR; PG8_MMA(1, 1, At, B1); PG8_BAR;
            }
        }
        if constexpr (ALIGN_EPI) { if (wr == 0) PG8_BAR; }
        if constexpr (!Epi::AFTER_DRAIN) { int fr_ = fr, fq_ = fq; if constexpr (Epi::MIDK) { int t_ = (int)threadIdx.x; asm volatile("" : "+v"(t_)); fr_ = t_ & 15; fq_ = (t_ >> 4) & 3; }
            E(acc, cur, wr, wc, fr_, fq_); S.done(cur); }
        if (!has_next) break;
#pragma unroll
        for (int a = 0; a < 2; ++a)
#pragma unroll
            for (int b = 0; b < 2; ++b)
#pragma unroll
                for (int m = 0; m < 4; ++m)
#pragma unroll
                    for (int n = 0; n < 2; ++n) acc[a][b][m][n] = (f32x4){0.f, 0.f, 0.f, 0.f};
        cur = nxt; cA = nA; cB = nB; ++ui;
        if constexpr (ALIGN_EPI) { if (wr == 1) PG8_BAR; }
    }
    PG8_WAIT_V(0);
    if constexpr (!ALIGN_EPI) { if (wr == 0) PG8_BAR; }
    PG8_BAR;
    if constexpr (Epi::AFTER_DRAIN) { E.fused(acc, cur, wr, wc, fr, fq, lds, wid, lane); S.done(cur); }
#undef PG8_SA
#undef PG8_SB
#undef PG8_STAGE
#undef PG8_LDA
#undef PG8_LDB
#undef PG8_MMA
#undef PG8_WAIT_V
#undef PG8_WAIT_L
#undef PG8_BAR
#undef PG8_SCHED
}
}

#define LAS __attribute__((address_space(3)))
typedef unsigned short bf16_t;
typedef short bf16x8 __attribute__((ext_vector_type(8)));
typedef short s16x4 __attribute__((ext_vector_type(4)));
typedef float f32x4 __attribute__((ext_vector_type(4)));
typedef float f32x2 __attribute__((ext_vector_type(2)));
typedef float f32x16 __attribute__((ext_vector_type(16)));
typedef unsigned u32x4 __attribute__((ext_vector_type(4)));
typedef unsigned u32x2 __attribute__((ext_vector_type(2)));
typedef __bf16 bf16x2_t __attribute__((ext_vector_type(2)));
typedef _Float16 f16x2_t __attribute__((ext_vector_type(2)));

#ifndef ENABLE_NSA
#define ENABLE_NSA 1
#endif
#ifndef ENABLE_PEER
#define ENABLE_PEER 1
#endif
#ifndef PEER_SIMPLE_REDUCE
#define PEER_SIMPLE_REDUCE 0
#endif
#ifndef PEER_CHECK
#define PEER_CHECK 0
#endif
#ifndef PEER_MANUAL_DOT
#define PEER_MANUAL_DOT 1
#endif
#ifndef REPEAT_PH
#define REPEAT_PH 0
#endif
#ifndef USE_XCD_BARRIER
#define USE_XCD_BARRIER 1
#endif
#ifndef TS_PROBE
#define TS_PROBE -1
#endif
#ifndef PROBE_P7
#define PROBE_P7 0
#endif
#ifndef REPEAT_LAUNCH
#define REPEAT_LAUNCH -1
#endif
#ifndef MFMA_NIBSWAP
#define MFMA_NIBSWAP 0
#endif
#ifndef MFMA_DEBUG
#define MFMA_DEBUG 0
#endif
#ifndef ALT_VAL
#define ALT_VAL 1
#endif
#ifndef UBENCH
#define UBENCH 0
#endif
#ifndef N_LAUNCH_MODE
#define N_LAUNCH_MODE 1
#endif

constexpr int NB = 8, SEQ = 4096, DM = 1024, NT = NB * SEQ;
constexpr int IN_COLS = 4888, NPAD = 5120, ZP = 2816;
constexpr int NEXP = 16384;
constexpr float RMS_EPS = 1e-6f;
constexpr float C2 = 0.125f * 1.4426950408889634f;
constexpr float LAMBDA_INIT = 0.2f;
constexpr int ZC_QDA = 0, ZC_KDA = 512, ZC_VDA = 1024, ZC_QN = 1536, ZC_KC = 2048, ZC_VC = 2176, ZC_KS = 2304, ZC_VS = 2432, ZC_KW = 2560, ZC_VW = 2688;

constexpr size_t MiB = 1u << 20;
constexpr size_t WS_BAR = 0;
constexpr size_t WS_ROPE = 1 * MiB;
constexpr size_t WS_MISC = 2 * MiB;
constexpr size_t WS_SS = 3 * MiB;
constexpr size_t WS_WIN_T = 8 * MiB;
constexpr size_t WS_PDA_T = 18 * MiB;
constexpr size_t WS_PNSA_T = 19 * MiB;
constexpr size_t WS_WO_T = 20 * MiB;
constexpr size_t WS_WP_T = 22 * MiB;
constexpr size_t WS_CW1_T = 26 * MiB;
constexpr size_t WS_CW2_T = 26 * MiB + 512 * 1024;
constexpr size_t WS_KC = 27 * MiB;
constexpr size_t WS_GN = 28 * MiB;
constexpr size_t WS_UT = 32 * MiB;
constexpr size_t WS_CMAX = 64 * 1024;
constexpr size_t WS_WSC = 5 * MiB;
constexpr size_t WS_ASC = 6 * MiB;
constexpr size_t WS_TSC = 4 * MiB;
constexpr size_t WS_A = 96 * MiB;
constexpr size_t WS_Y = 96 * MiB;
constexpr size_t WS_YN = 128 * MiB;
constexpr size_t WS_GM = 160 * MiB;
constexpr size_t WS_SC = 160 * MiB;
constexpr size_t WS_ZA = 288 * MiB;
constexpr size_t WS_TMP = 288 * MiB, WS_MERGED = 352 * MiB, WS_HG = 416 * MiB;
constexpr size_t WS_END = 480 * MiB;

constexpr int LDS_BYTES = 147456;
constexpr int NWAVES = 8;

__device__ __forceinline__ unsigned pk_bf16(float lo, float hi) { f32x2 v = {lo, hi}; bf16x2_t b = __builtin_convertvector(v, bf16x2_t); return __builtin_bit_cast(unsigned, b); }
__device__ __forceinline__ unsigned pk_f16(float lo, float hi) { f32x2 v = {lo, hi}; f16x2_t b = __builtin_convertvector(v, f16x2_t); return __builtin_bit_cast(unsigned, b); }
__device__ __forceinline__ float bf_lo(unsigned u) { return __builtin_bit_cast(float, u << 16); }
__device__ __forceinline__ float bf_hi(unsigned u) { return __builtin_bit_cast(float, u & 0xffff0000u); }

__device__ __forceinline__ float sigmoidf_(float x) { return __builtin_amdgcn_rcpf(1.0f + __expf(-x)); }
__device__ __forceinline__ float gelu_erf(float v) { return 0.5f * v * (1.0f + erff(v * 0.70710678118654752f)); }
__device__ __forceinline__ float gelu_poly(float v) {
    const float av = fabsf(v), t = __builtin_amdgcn_rcpf(av * 0.2316418882f + 1.0f);
    float q = t * 0.5307027145f + (-0.7265760135f); q = q * t + 0.7107068705f; q = q * t + (-0.142248368f); q = q * t + 0.127414796f; q = q * t;
    const float e = __builtin_amdgcn_exp2f((v * v) * (-0.72134752044f));
    const float m = v * (q * e), r = v - m;
    return v < 0.f ? m : r;
}
__device__ __forceinline__ float swap32_other(float x) {
    auto rr = __builtin_amdgcn_permlane32_swap(__float_as_uint(x), __float_as_uint(x), false, false);
    return (threadIdx.x & 32) ? __uint_as_float(rr[0]) : __uint_as_float(rr[1]);
}
template <int CTRL> __device__ __forceinline__ float dppf(float x) { return __int_as_float(__builtin_amdgcn_mov_dpp(__float_as_int(x), CTRL, 0xF, 0xF, true)); }
template <int CTRL> __device__ __forceinline__ unsigned dppu(unsigned x) { return (unsigned)__builtin_amdgcn_mov_dpp((int)x, CTRL, 0xF, 0xF, true); }
constexpr int DPP_XOR1 = 0xB1, DPP_XOR2 = 0x4E, DPP_HMIRROR = 0x141, DPP_MIRROR = 0x140, DPP_ROR8 = 0x128;
__device__ __forceinline__ float swz16f(float x) { return __int_as_float(__builtin_amdgcn_ds_swizzle(__float_as_int(x), 0x401F)); }
__device__ __forceinline__ unsigned swz16u(unsigned x) { return (unsigned)__builtin_amdgcn_ds_swizzle((int)x, 0x401F); }
__device__ __forceinline__ float row16_sum(float v) { v += dppf<DPP_XOR1>(v); v += dppf<DPP_XOR2>(v); v += dppf<DPP_HMIRROR>(v); v += dppf<DPP_MIRROR>(v); return v; }
__device__ __forceinline__ float wave_max(float v) { v = fmaxf(v, dppf<DPP_XOR1>(v)); v = fmaxf(v, dppf<DPP_XOR2>(v)); v = fmaxf(v, dppf<DPP_HMIRROR>(v)); v = fmaxf(v, dppf<DPP_MIRROR>(v)); v = fmaxf(v, swz16f(v)); v = fmaxf(v, swap32_other(v)); return v; }
__device__ __forceinline__ float wave_sum(float v) { v = row16_sum(v); v += swz16f(v); v += swap32_other(v); return v; }
__device__ __forceinline__ unsigned row16_maxu(unsigned v) { unsigned t;
    t = dppu<DPP_XOR1>(v); v = v > t ? v : t; t = dppu<DPP_XOR2>(v); v = v > t ? v : t; t = dppu<DPP_HMIRROR>(v); v = v > t ? v : t; t = dppu<DPP_MIRROR>(v); v = v > t ? v : t; return v; }

struct Params {
    const float* in[24]; float* out; unsigned char* ws; int ph_lo, ph_hi, alt, pad;
};

struct EpiInProj {
    static constexpr bool PERM = true, AFTER_DRAIN = false, MIDK = false;
    bf16_t* ZA; bf16_t* GM; float* GN; const float* rope; int plain; const float* asc; const float* wsc;
    __device__ __forceinline__ void operator()(const f32x4 (&acc)[2][2][4][2], const pg8::Unit& u, int wr, int wc, int fr, int fq) const {
        const int pn = u.pn;
        const bool is_rope_lane = ((wc & 1) == 0) && (fq < 2);
        const float sgn = (fq == 0) ? -1.f : 1.f;
#pragma unroll
        for (int ai = 0; ai < 2; ++ai) {
            f32x4 rpv[4][4];
#pragma unroll
            for (int m = 0; m < 4; ++m) {
                if ((m & 1) == 0 && pn <= 10 && is_rope_lane && !plain) {
#pragma unroll
                    for (int mm = m; mm < m + 2; ++mm) {
                        const int pos = (u.pm * 256 + ai * 128 + wr * 64 + mm * 16 + fr) & (SEQ - 1);
                        const f32x4* rp = (const f32x4*)(rope + (size_t)pos * 16);
                        rpv[mm][0] = rp[0]; rpv[mm][1] = rp[1]; rpv[mm][2] = rp[2]; rpv[mm][3] = rp[3];
                    }
                }
                const int row = u.pm * 256 + ai * 128 + wr * 64 + m * 16 + fr;
                const float ra = asc[row];
#pragma unroll
                for (int bj = 0; bj < 2; ++bj) {
                    const int ct = bj * 128 + wc * 32 + fq * 8;
                    float v[8];
                    const f32x4 ws0 = *(const f32x4*)(wsc + pn * 256 + ct), ws1 = *(const f32x4*)(wsc + pn * 256 + ct + 4);
#pragma unroll
                    for (int i = 0; i < 4; ++i) { v[i] = (float)__float_as_int(acc[ai][bj][m][0][i]) * (ra * ws0[i]); v[4 + i] = (float)__float_as_int(acc[ai][bj][m][1][i]) * (ra * ws1[i]); }
                    if (pn <= 10) {
                        const bool rope_tile = (pn < 4) || (pn == 6) || (pn == 7) || (pn >= 8 && bj == 0);
                        if (rope_tile && !plain) {
                            float pv[8];
#pragma unroll
                            for (int i = 0; i < 8; ++i) pv[i] = swz16f(v[i]);
                            if (is_rope_lane) {
                                const f32x4 c0 = rpv[m][0], c1 = rpv[m][1], s0 = rpv[m][2], s1 = rpv[m][3];
#pragma unroll
                                for (int i = 0; i < 4; ++i) { v[i] = v[i] * c0[i] + sgn * pv[i] * s0[i]; v[4 + i] = v[4 + i] * c1[i] + sgn * pv[4 + i] * s1[i]; }
                            }
                        }
                        const float sc = (pn < 2 || pn == 6 || pn == 7) ? C2 : 1.0f;
                        u32x4 w; w.x = pk_bf16(v[0] * sc, v[1] * sc); w.y = pk_bf16(v[2] * sc, v[3] * sc); w.z = pk_bf16(v[4] * sc, v[5] * sc); w.w = pk_bf16(v[6] * sc, v[7] * sc);
                        *(u32x4*)(ZA + (size_t)row * ZP + pn * 256 + ct) = w;
                    } else if (pn <= 18) {
                        if (!plain) {
#pragma unroll
                        for (int i = 0; i < 8; ++i) v[i] = sigmoidf_(v[i]);
                        }
                        unsigned w0 = 0u, w1 = 0u;
#pragma unroll
                        for (int i = 0; i < 4; ++i) { w0 = __builtin_amdgcn_cvt_pk_u8_f32(v[i] * 255.0f, i, w0); w1 = __builtin_amdgcn_cvt_pk_u8_f32(v[4 + i] * 255.0f, i, w1); }
                        *(u32x2*)((unsigned char*)GM + (size_t)row * 2048 + (pn - 11) * 256 + ct) = (u32x2){w0, w1};
                    } else {
                        if (bj == 0 && wc == 0) {
                            f32x4 a = {sigmoidf_(v[0]), sigmoidf_(v[1]), sigmoidf_(v[2]), sigmoidf_(v[3])}, b = {sigmoidf_(v[4]), sigmoidf_(v[5]), sigmoidf_(v[6]), sigmoidf_(v[7])};
                            *(f32x4*)(GN + (size_t)row * 32 + fq * 8) = a; *(f32x4*)(GN + (size_t)row * 32 + fq * 8 + 4) = b;
                        }
                    }
                }
            }
        }
    }
};
struct EpiMerge {
    static constexpr bool PERM = true, AFTER_DRAIN = false, MIDK = true;
    const unsigned char* GM; bf16_t* OUT;
    __device__ __forceinline__ void mid(f32x4 (&acc)[2][2][4][2], const pg8::Unit& u, int wr, int wc, int fr, int fq) const {
#pragma unroll
        for (int ai = 0; ai < 2; ++ai)
#pragma unroll
            for (int mp = 0; mp < 4; mp += 2) {
                u32x2 ga[2][2], gb[2][2];
#pragma unroll
                for (int m = 0; m < 2; ++m)
#pragma unroll
                    for (int bj = 0; bj < 2; ++bj) {
                        const int row = u.pm * 256 + ai * 128 + wr * 64 + (mp + m) * 16 + fr, col = u.pn * 256 + bj * 128 + wc * 32 + fq * 8;
                        ga[m][bj] = *(const u32x2*)(GM + (size_t)row * 2048 + col); gb[m][bj] = *(const u32x2*)(GM + (size_t)row * 2048 + 1024 + col);
                    }
#pragma unroll
                for (int m = 0; m < 2; ++m)
#pragma unroll
                    for (int bj = 0; bj < 2; ++bj)
#pragma unroll
                        for (int i = 0; i < 4; ++i) {
                            const unsigned b0 = (gb[m][bj].x >> (8 * i)) & 255u, b1 = (gb[m][bj].y >> (8 * i)) & 255u;
                            acc[ai][bj][mp + m][0][i] *= (float)((ga[m][bj].x >> (8 * i)) & 255u) * __builtin_amdgcn_rcpf((float)(b0 ? b0 : 1u));
                            acc[ai][bj][mp + m][1][i] *= (float)((ga[m][bj].y >> (8 * i)) & 255u) * __builtin_amdgcn_rcpf((float)(b1 ? b1 : 1u));
                        }
            }
    }
    __device__ __forceinline__ void operator()(const f32x4 (&acc)[2][2][4][2], const pg8::Unit& u, int wr, int wc, int fr, int fq) const {
#pragma unroll
        for (int ai = 0; ai < 2; ++ai) {
            u32x2 gb[4][2];
#pragma unroll
            for (int m = 0; m < 4; ++m)
#pragma unroll
                for (int bj = 0; bj < 2; ++bj) {
                    const int row = u.pm * 256 + ai * 128 + wr * 64 + m * 16 + fr, col = u.pn * 256 + bj * 128 + wc * 32 + fq * 8;
                    gb[m][bj] = *(const u32x2*)(GM + (size_t)row * 2048 + 1024 + col);
                }
#pragma unroll
            for (int m = 0; m < 4; ++m)
#pragma unroll
                for (int bj = 0; bj < 2; ++bj) {
                    const int row = u.pm * 256 + ai * 128 + wr * 64 + m * 16 + fr, col = u.pn * 256 + bj * 128 + wc * 32 + fq * 8;
                    float v[8];
#pragma unroll
                    for (int i = 0; i < 4; ++i) {
                        const unsigned b0 = (gb[m][bj].x >> (8 * i)) & 255u, b1 = (gb[m][bj].y >> (8 * i)) & 255u;
                        v[i] = acc[ai][bj][m][0][i] * (float)(b0 ? b0 : 1u); v[4 + i] = acc[ai][bj][m][1][i] * (float)(b1 ? b1 : 1u);
                    }
                    u32x4 w; w.x = pk_bf16(v[0], v[1]); w.y = pk_bf16(v[2], v[3]); w.z = pk_bf16(v[4], v[5]); w.w = pk_bf16(v[6], v[7]);
                    *(u32x4*)(OUT + (size_t)row * 1024 + col) = w;
                }
        }
    }
};
template <int SECOND> struct EpiGate {
    static constexpr bool PERM = true, AFTER_DRAIN = false, MIDK = false;
    const bf16_t* GM; bf16_t* TMP; bf16_t* OUT;
    __device__ __forceinline__ void operator()(const f32x4 (&acc)[2][2][4][2], const pg8::Unit& u, int wr, int wc, int fr, int fq) const {
#pragma unroll
        for (int ai = 0; ai < 2; ++ai) {
            u32x2 gv[4][2]; u32x4 tv[4][2];
#pragma unroll
            for (int m = 0; m < 4; ++m)
#pragma unroll
                for (int bj = 0; bj < 2; ++bj) {
                    const int row = u.pm * 256 + ai * 128 + wr * 64 + m * 16 + fr, col = u.pn * 256 + bj * 128 + wc * 32 + fq * 8;
                    gv[m][bj] = *(const u32x2*)((const unsigned char*)GM + (size_t)row * 2048 + SECOND * 1024 + col);
                    if (SECOND) tv[m][bj] = *(const u32x4*)(TMP + (size_t)row * 1024 + col);
                }
#pragma unroll
            for (int m = 0; m < 4; ++m)
#pragma unroll
                for (int bj = 0; bj < 2; ++bj) {
                    const int row = u.pm * 256 + ai * 128 + wr * 64 + m * 16 + fr, col = u.pn * 256 + bj * 128 + wc * 32 + fq * 8;
                    const u32x2 g = gv[m][bj];
                    float v[8];
#pragma unroll
                    for (int i = 0; i < 4; ++i) { v[i] = acc[ai][bj][m][0][i] * (float)((g.x >> (8 * i)) & 255u); v[4 + i] = acc[ai][bj][m][1][i] * (float)((g.y >> (8 * i)) & 255u); }
                    if (SECOND) {
                        const u32x4 t = tv[m][bj];
                        v[0] += bf_lo(t.x); v[1] += bf_hi(t.x); v[2] += bf_lo(t.y); v[3] += bf_hi(t.y); v[4] += bf_lo(t.z); v[5] += bf_hi(t.z); v[6] += bf_lo(t.w); v[7] += bf_hi(t.w);
                    }
                    u32x4 w; w.x = pk_bf16(v[0], v[1]); w.y = pk_bf16(v[2], v[3]); w.z = pk_bf16(v[4], v[5]); w.w = pk_bf16(v[6], v[7]);
                    *(u32x4*)(OUT + (size_t)row * 1024 + col) = w;
                }
        }
    }
};
struct EpiWo {
    static constexpr bool PERM = true, AFTER_DRAIN = false, MIDK = false;
    const float* X; bf16_t* HB; float* ss;
    __device__ __forceinline__ void operator()(const f32x4 (&acc)[2][2][4][2], const pg8::Unit& u, int wr, int wc, int fr, int fq) const {
#pragma unroll
        for (int ai = 0; ai < 2; ++ai) {
            f32x4 xv[4][2][2];
#pragma unroll
            for (int m = 0; m < 4; ++m)
#pragma unroll
                for (int bj = 0; bj < 2; ++bj) {
                    const int row = u.pm * 256 + ai * 128 + wr * 64 + m * 16 + fr, col = u.pn * 256 + bj * 128 + wc * 32 + fq * 8;
                    xv[m][bj][0] = *(const f32x4*)(X + (size_t)row * DM + col); xv[m][bj][1] = *(const f32x4*)(X + (size_t)row * DM + col + 4);
                }
#pragma unroll
            for (int m = 0; m < 4; ++m) {
                const int row = u.pm * 256 + ai * 128 + wr * 64 + m * 16 + fr;
                float sq = 0.f;
#pragma unroll
                for (int bj = 0; bj < 2; ++bj) {
                    const int col = u.pn * 256 + bj * 128 + wc * 32 + fq * 8;
                    const f32x4 h0 = xv[m][bj][0] + acc[ai][bj][m][0], h1 = xv[m][bj][1] + acc[ai][bj][m][1];
                    sq += (h0[0] * h0[0] + h0[1] * h0[1]) + (h0[2] * h0[2] + h0[3] * h0[3]) + (h1[0] * h1[0] + h1[1] * h1[1]) + (h1[2] * h1[2] + h1[3] * h1[3]);
                    u32x4 w; w.x = pk_bf16(h0[0], h0[1]); w.y = pk_bf16(h0[2], h0[3]); w.z = pk_bf16(h1[0], h1[1]); w.w = pk_bf16(h1[2], h1[3]);
                    *(u32x4*)(HB + (size_t)row * DM + col) = w;
                }
                sq += __shfl_xor(sq, 16); sq += __shfl_xor(sq, 32);
                if (fq == 0) atomicAdd(ss + row, sq);
            }
        }
    }
};
struct EpiScores {
    static constexpr bool PERM = true, AFTER_DRAIN = false, MIDK = false;
    const float* ss; unsigned short* SC;
    __device__ __forceinline__ void operator()(const f32x4 (&acc)[2][2][4][2], const pg8::Unit& u, int wr, int wc, int fr, int fq) const {
        float ssv[2][4];
#pragma unroll
        for (int ai = 0; ai < 2; ++ai)
#pragma unroll
            for (int m = 0; m < 4; ++m) ssv[ai][m] = ss[u.pm * 256 + ai * 128 + wr * 64 + m * 16 + fr];
#pragma unroll
        for (int ai = 0; ai < 2; ++ai)
#pragma unroll
            for (int m = 0; m < 4; ++m) {
                const int row = u.pm * 256 + ai * 128 + wr * 64 + m * 16 + fr;
                const float rs = rsqrtf(ssv[ai][m] * (1.0f / DM) + RMS_EPS);
#pragma unroll
                for (int bj = 0; bj < 2; ++bj) {
                    const int col = u.pn * 256 + bj * 128 + wc * 32 + fq * 8;
                    const f32x4 a = acc[ai][bj][m][0] * rs, b = acc[ai][bj][m][1] * rs;
                    u32x4 w; w.x = pk_f16(a[0], a[1]); w.y = pk_f16(a[2], a[3]); w.z = pk_f16(b[0], b[1]); w.w = pk_f16(b[2], b[3]);
                    *(u32x4*)(SC + (size_t)row * 2048 + col) = w;
                }
            }
    }
};

template <int NR>
__device__ __forceinline__ void convert_table_rows(const Params& P, int rr0, int lane) {
    unsigned char* ws = P.ws;
    f32x4 a[NR][4]; float ss[NR];
    f32x4 gq[4];
#pragma unroll
    for (int q = 0; q < 4; ++q) gq[q] = *(const f32x4*)(P.in[17] + lane * 16 + 4 * q);
#pragma unroll
    for (int u = 0; u < NR; ++u) {
        const int rr = rr0 + u, tbl = rr >= NEXP ? 1 : 0, r = rr - tbl * NEXP;
        const f32x4* sp = (const f32x4*)(P.in[21 + tbl] + (size_t)r * DM + lane * 16);
#pragma unroll
        for (int q = 0; q < 4; ++q) a[u][q] = tbl ? sp[q] : sp[q] * gq[q];
    }
#pragma unroll
    for (int u = 0; u < NR; ++u) { ss[u] = 0.f;
#pragma unroll
        for (int q = 0; q < 4; ++q) ss[u] += (a[u][q][0] * a[u][q][0] + a[u][q][1] * a[u][q][1]) + (a[u][q][2] * a[u][q][2] + a[u][q][3] * a[u][q][3]); }
#pragma unroll
    for (int u = 0; u < NR; ++u) {
        const int rr = rr0 + u, tbl = rr >= NEXP ? 1 : 0, r = rr - tbl * NEXP;
        const float rms = sqrtf(wave_sum(ss[u]) * (1.0f / DM));
        const float sc = (tbl ? 0.5f : 0.335f) * rms + 1e-30f, inv = 1.0f / sc;
        u32x2 o;
#pragma unroll
        for (int h = 0; h < 2; ++h) {
            unsigned w = 0u;
            if (tbl) {
                w = __builtin_amdgcn_cvt_scalef32_pk_fp4_f32(w, a[u][2 * h][0] * inv, a[u][2 * h][1] * inv, 1.0f, 0);
                w = __builtin_amdgcn_cvt_scalef32_pk_fp4_f32(w, a[u][2 * h][2] * inv, a[u][2 * h][3] * inv, 1.0f, 1);
                w = __builtin_amdgcn_cvt_scalef32_pk_fp4_f32(w, a[u][2 * h + 1][0] * inv, a[u][2 * h + 1][1] * inv, 1.0f, 2);
                w = __builtin_amdgcn_cvt_scalef32_pk_fp4_f32(w, a[u][2 * h + 1][2] * inv, a[u][2 * h + 1][3] * inv, 1.0f, 3);
            } else {
#pragma unroll
                for (int i = 0; i < 8; ++i) {
                    int q = (int)floorf(a[u][2 * h + (i >> 2)][i & 3] * inv);
                    q = q < -8 ? -8 : (q > 7 ? 7 : q);
                    w |= ((unsigned)q & 15u) << (4 * i);
                }
            }
            o[h] = w;
        }
        ((u32x2*)(ws + WS_UT) + tbl)[((size_t)r * 64 + lane) * 2] = o;
        if (lane == 0) ((float*)(ws + WS_TSC) + tbl * NEXP)[r] = sc;
    }
}
struct TableOrder : pg8::StaticOrder {
    const Params* P; int gw; mutable int calls;
    __device__ __forceinline__ void done(const pg8::Unit&) const {
        const int slot = gw * 4 + calls; ++calls;
        if (calls <= 4) convert_table_rows<4>(*P, slot * 4, (int)(threadIdx.x & 63));
    }
};
__device__ __forceinline__ int remap_win(int n) { return n < 2816 ? n : (n < 2840 ? 4864 + (n - 2816) : n - 24); }
template <int MODE>
__device__ __forceinline__ void transpose_item(const float* W, int K, int N, bf16_t* WT, LAS float* scr, int item, int lane, const unsigned* cmax = nullptr, float* wsc = nullptr, int ldt = 0, int koff = 0) {
    const int nblk = (N + 31) / 32, kb = item / nblk, nb = item % nblk, k0 = 64 * kb, n0 = 32 * nb;
    const int nn = n0 + (lane & 31);
#pragma unroll 8
    for (int i = 0; i < 32; ++i) { const int kk = 2 * i + (lane >> 5); scr[kk * 33 + (lane & 31)] = (nn < N) ? W[(size_t)(k0 + kk) * N + nn] : 0.f; }
    asm volatile("s_waitcnt lgkmcnt(0)" ::: "memory");
    const int c = lane & 7;
#pragma unroll
    for (int j = 0; j < 4; ++j) {
        const int n = (lane >> 3) + 8 * j; const LAS float* s = scr + (8 * c) * 33 + n;
        constexpr float WSCALE = MODE == 3 ? 1.0f / 255.0f : 1.0f;
        u32x4 o; o.x = pk_bf16(s[0 * 33] * WSCALE, s[1 * 33] * WSCALE); o.y = pk_bf16(s[2 * 33] * WSCALE, s[3 * 33] * WSCALE); o.z = pk_bf16(s[4 * 33] * WSCALE, s[5 * 33] * WSCALE); o.w = pk_bf16(s[6 * 33] * WSCALE, s[7 * 33] * WSCALE);
        if constexpr (MODE == 2) {
            if (n0 + n < N) {
                const float cm = __uint_as_float(cmax[n0 + n]), sc = cm > 0.f ? 127.0f / cm : 0.f;
                unsigned w0 = 0u, w1 = 0u;
#pragma unroll
                for (int e = 0; e < 4; ++e) { const int q0 = (int)rintf(s[e * 33] * sc), q1 = (int)rintf(s[(4 + e) * 33] * sc); w0 |= ((unsigned)q0 & 255u) << (8 * e); w1 |= ((unsigned)q1 & 255u) << (8 * e); }
                const int dst = remap_win(n0 + n);
                *(u32x2*)((unsigned char*)WT + (size_t)dst * K + k0 + 8 * c) = (u32x2){w0, w1};
                if (k0 == 0 && c == 0) wsc[dst] = cm * (1.0f / 127.0f);
            }
        } else
        if (n0 + n < N) { const int dst = MODE == 1 ? remap_win(n0 + n) : (n0 + n); *(u32x4*)(WT + (size_t)dst * (ldt ? ldt : K) + koff + k0 + 8 * c) = o; }
    }
    asm volatile("s_waitcnt lgkmcnt(0)" ::: "memory");
}

__device__ __forceinline__ void p0_prep(const Params& P, LAS unsigned char* lds, int gw, int NGW, int wave, int lane, int part) {
    unsigned char* ws = P.ws;
    LAS float* scr = (LAS float*)(lds + wave * 16384);
    if (part == 0) {
        {
            constexpr int NB = (IN_COLS + 31) / 32;
            unsigned* cmax = (unsigned*)(ws + WS_CMAX);
            for (int it = gw; it < 16 * NB; it += NGW) {
                const int kb = it / NB, nb = it % NB, nn = 32 * nb + (lane & 31);
                const float* wp = P.in[2] + (size_t)(64 * kb + (lane >> 5)) * IN_COLS + nn;
                float mx = 0.f;
                if (nn < IN_COLS) {
#pragma unroll 8
                    for (int i = 0; i < 32; ++i) mx = fmaxf(mx, fabsf(wp[(size_t)(2 * i) * IN_COLS]));
                }
                mx = fmaxf(mx, swap32_other(mx));
                if (lane < 32 && nn < IN_COLS) atomicMax(cmax + nn, __float_as_uint(mx));
            }
        }
        return;
    }
    {
        constexpr int I_WIN = (1024 / 64) * ((IN_COLS + 31) / 32);
        for (int it = gw; it < I_WIN; it += NGW) transpose_item<2>(P.in[2], 1024, IN_COLS, (bf16_t*)(ws + WS_WIN_T), scr, it, lane, (const unsigned*)(ws + WS_CMAX), (float*)(ws + WS_WSC));
        u32x4* z = (u32x4*)(ws + WS_WIN_T + (size_t)IN_COLS * 1024);
        const int n16 = (NPAD - IN_COLS) * 1024 / 16;
        for (int i = gw * 64 + lane; i < n16; i += NGW * 64) z[i] = (u32x4){0u, 0u, 0u, 0u};
        if (gw == 0) for (int i = IN_COLS + lane; i < NPAD; i += 64) ((float*)(ws + WS_WSC))[i] = 0.f;
    }
    {
        constexpr int I_P = (512 / 64) * (1024 / 32), I_WO = (1024 / 64) * (1024 / 32), I_C1 = (2048 / 64) * (64 / 32), I_C2 = 1 * 2;
        constexpr int NITEMS = 2 * I_P + I_WO + 2 * I_C1 + 2 * I_C2;
        for (int it = gw; it < NITEMS; it += NGW) {
            int r = it;
            if (r < I_P) { transpose_item<3>(P.in[14], 512, 1024, (bf16_t*)(ws + WS_PDA_T), scr, r, lane, nullptr, nullptr, 1024, 0); continue; } r -= I_P;
            if (r < I_P) { transpose_item<3>(P.in[15], 512, 1024, (bf16_t*)(ws + WS_PDA_T), scr, r, lane, nullptr, nullptr, 1024, 512); continue; } r -= I_P;
            if (r < I_WO) { transpose_item<0>(P.in[16], 1024, 1024, (bf16_t*)(ws + WS_WO_T), scr, r, lane); continue; } r -= I_WO;
            if (r < I_C1) { transpose_item<0>(P.in[10], 2048, 64, (bf16_t*)(ws + WS_CW1_T), scr, r, lane); continue; } r -= I_C1;
            if (r < I_C1) { transpose_item<0>(P.in[11], 2048, 64, (bf16_t*)(ws + WS_CW1_T) + 64 * 2048, scr, r, lane); continue; } r -= I_C1;
            if (r < I_C2) { transpose_item<0>(P.in[12], 64, 64, (bf16_t*)(ws + WS_CW2_T), scr, r, lane); continue; } r -= I_C2;
            transpose_item<0>(P.in[13], 64, 64, (bf16_t*)(ws + WS_CW2_T) + 64 * 64, scr, r, lane);
        }
    }
    {
        const float* wq = P.in[18]; bf16_t* WPT = (bf16_t*)(ws + WS_WP_T);
        const int i = lane & 31, kh = lane >> 5;
        for (int task = gw; task < 32 * 64; task += NGW) {
            const int jt = task >> 6, nt = task & 63, j0 = jt * 32, n0 = nt * 32;
            const int c = (n0 >> 7) & 1, k0 = n0 & 127, hc_off = n0 & ~127;
            const float* sk = c ? P.in[20] : P.in[19];
            const float* ap = wq + (size_t)(j0 + i) * 2048 + hc_off + 4 * kh;
            const float gj = P.in[17][j0 + i];
            const float* bp = sk + (size_t)(k0 + i) * 128 + 4 * kh;
            f32x16 acc = {0};
#pragma unroll 4
            for (int u = 0; u < 16; ++u) {
                const f32x4 a4 = *(const f32x4*)(ap + 8 * u) * gj, b4 = *(const f32x4*)(bp + 8 * u);
#pragma unroll
                for (int e = 0; e < 4; ++e) acc = __builtin_amdgcn_mfma_f32_32x32x2f32(a4[e], b4[e], acc, 0, 0, 0);
            }
#pragma unroll
            for (int g = 0; g < 4; ++g) {
                u32x2 o; o.x = pk_bf16(acc[4 * g + 0], acc[4 * g + 1]); o.y = pk_bf16(acc[4 * g + 2], acc[4 * g + 3]);
                *(u32x2*)(WPT + (size_t)(n0 + i) * 1024 + j0 + 8 * g + 4 * kh) = o;
            }
        }
    }
    {
        float* rope = (float*)(ws + WS_ROPE);
        for (int idx = gw * 64 + lane; idx < SEQ * 8; idx += NGW * 64) {
            const int pos = idx >> 3, i = idx & 7;
            const float inv = (float)pow(500000.0, -(double)i / 8.0);
            const float ang = (float)pos * inv;
            rope[pos * 16 + i] = (float)cos((double)ang); rope[pos * 16 + 8 + i] = (float)sin((double)ang);
        }
    }
    {
        float* misc = (float*)(ws + WS_MISC);
        for (int task = gw; task < 128; task += NGW) {
            const int t = task >> 6, n = task & 63; const float* pe = P.in[8 + t]; const float* w1 = P.in[10 + t];
            float s = 0.f;
            for (int kk = lane; kk < 2048; kk += 64) s += pe[kk] * w1[(size_t)kk * 64 + n];
            s = wave_sum(s);
            if (lane == 0) misc[64 + task] = s;
        }
        if (gw == 0) {
            float a = P.in[3][lane] * P.in[4][lane], b = P.in[5][lane] * P.in[6][lane];
            a = wave_sum(a); b = wave_sum(b);
            if (lane == 0) misc[0] = __expf(a) - __expf(b) + LAMBDA_INIT;
        }
        float* ss = (float*)(ws + WS_SS);
        for (int i = gw * 64 + lane; i < NT; i += NGW * 64) ss[i] = 0.f;
    }
    {
        const float* gn = P.in[1]; bf16_t* A = (bf16_t*)(ws + WS_A);
        f32x4 g[4];
#pragma unroll
        for (int j = 0; j < 4; ++j) g[j] = ((const f32x4*)gn)[64 * j + lane];
        for (int mrow = gw; mrow < NT; mrow += 2 * NGW) {
            const f32x4* xr0 = (const f32x4*)(P.in[0] + (size_t)mrow * DM) + lane; const f32x4* xr1 = (const f32x4*)(P.in[0] + (size_t)(mrow + NGW) * DM) + lane;
            f32x4 v0[4], v1[4]; float s0 = 0.f, s1 = 0.f;
#pragma unroll
            for (int j = 0; j < 4; ++j) { v0[j] = xr0[64 * j]; v1[j] = xr1[64 * j]; }
#pragma unroll
            for (int j = 0; j < 4; ++j) { s0 += (v0[j][0] * v0[j][0] + v0[j][1] * v0[j][1]) + (v0[j][2] * v0[j][2] + v0[j][3] * v0[j][3]); s1 += (v1[j][0] * v1[j][0] + v1[j][1] * v1[j][1]) + (v1[j][2] * v1[j][2] + v1[j][3] * v1[j][3]); }
            const float rs0 = rsqrtf(wave_sum(s0) * (1.0f / DM) + RMS_EPS), rs1 = rsqrtf(wave_sum(s1) * (1.0f / DM) + RMS_EPS);
            float m0 = 0.f, m1 = 0.f;
#pragma unroll
            for (int j = 0; j < 4; ++j)
#pragma unroll
                for (int e = 0; e < 4; ++e) { v0[j][e] *= rs0 * g[j][e]; v1[j][e] *= rs1 * g[j][e]; m0 = fmaxf(m0, fabsf(v0[j][e])); m1 = fmaxf(m1, fabsf(v1[j][e])); }
            m0 = wave_max(m0); m1 = wave_max(m1);
            const float q0 = m0 > 0.f ? 127.0f / m0 : 0.f, q1 = m1 > 0.f ? 127.0f / m1 : 0.f;
            unsigned* o0 = (unsigned*)((unsigned char*)A + (size_t)mrow * DM) + lane; unsigned* o1 = (unsigned*)((unsigned char*)A + (size_t)(mrow + NGW) * DM) + lane;
#pragma unroll
            for (int j = 0; j < 4; ++j) {
                unsigned a = 0u, b = 0u;
#pragma unroll
                for (int e = 0; e < 4; ++e) { a |= ((unsigned)(int)rintf(v0[j][e] * q0) & 255u) << (8 * e); b |= ((unsigned)(int)rintf(v1[j][e] * q1) & 255u) << (8 * e); }
                o0[64 * j] = a; o1[64 * j] = b;
            }
            if (lane == 0) { ((float*)(ws + WS_ASC))[mrow] = m0 * (1.0f / 127.0f); ((float*)(ws + WS_ASC))[mrow + NGW] = m1 * (1.0f / 127.0f); }
        }
    }
}

__device__ __forceinline__ void compress_tasks(const Params& P, LAS unsigned char* lds, int wgid, int wave, int lane) {
    unsigned char* ws = P.ws;
    const bf16_t* ZA = (const bf16_t*)(ws + WS_ZA);
    const float* misc = (const float*)(ws + WS_MISC);
    typedef float f32x4v __attribute__((ext_vector_type(4)));
    const int task = 2 * wgid + (wave >> 2), kch = wave & 3;
    const int t = task >> 8, rem = task & 255, b = rem >> 5, g = (rem >> 4) & 1, nt = rem & 15;
    const int m = lane & 15, q = lane >> 4;
    const int n = nt * 16 + m, ne = n < 255 ? n : 254;
    const bf16_t* W1T = (const bf16_t*)(ws + WS_CW1_T) + (size_t)t * 64 * 2048;
    const bf16_t* src = ZA + (size_t)(b * SEQ + 16 * ne) * ZP + (t ? ZC_VC : ZC_KC) + g * 64;
    f32x4v d1[4];
#pragma unroll
    for (int i = 0; i < 4; ++i) d1[i] = (f32x4v){0.f, 0.f, 0.f, 0.f};
    if (task < 512) {
        bf16x8 fb[16];
#pragma unroll
        for (int kk = 0; kk < 16; ++kk) { const int k = kch * 512 + kk * 32 + 8 * q; fb[kk] = *(const bf16x8*)(src + (size_t)(k >> 6) * ZP + (k & 63)); }
#pragma unroll
        for (int kk = 0; kk < 16; ++kk) {
            const int k = kch * 512 + kk * 32 + 8 * q;
#pragma unroll
            for (int t4 = 0; t4 < 4; ++t4) {
                const bf16x8 wa = *(const bf16x8*)(W1T + (size_t)(16 * t4 + m) * 2048 + k);
                d1[t4] = __builtin_amdgcn_mfma_f32_16x16x32_bf16(wa, fb[kk], d1[t4], 0, 0, 0);
            }
        }
    }
    LAS float* part = (LAS float*)lds;
#pragma unroll
    for (int t4 = 0; t4 < 4; ++t4)
#pragma unroll
        for (int r = 0; r < 4; ++r) part[(wave * 16 + t4 * 4 + r) * 64 + lane] = d1[t4][r];
    __syncthreads();
    if (kch == 0 && task < 512) {
        const int w0 = wave;
        float gl[4][4];
#pragma unroll
        for (int t4 = 0; t4 < 4; ++t4)
#pragma unroll
            for (int r = 0; r < 4; ++r) {
                float s = 0.f;
#pragma unroll
                for (int w = 0; w < 4; ++w) s += part[((w0 + w) * 16 + t4 * 4 + r) * 64 + lane];
                s += misc[64 + t * 64 + 16 * t4 + 4 * q + r];
                gl[t4][r] = gelu_poly(s);
            }
        const bf16_t* W2T = (const bf16_t*)(ws + WS_CW2_T) + (size_t)t * 64 * 64;
        f32x4v d2[4];
#pragma unroll
        for (int i = 0; i < 4; ++i) d2[i] = (f32x4v){0.f, 0.f, 0.f, 0.f};
#pragma unroll
        for (int s = 0; s < 2; ++s) {
            u32x4 bw; bw.x = pk_bf16(gl[2 * s][0], gl[2 * s][1]); bw.y = pk_bf16(gl[2 * s][2], gl[2 * s][3]); bw.z = pk_bf16(gl[2 * s + 1][0], gl[2 * s + 1][1]); bw.w = pk_bf16(gl[2 * s + 1][2], gl[2 * s + 1][3]);
            const bf16x8 gb = __builtin_bit_cast(bf16x8, bw);
#pragma unroll
            for (int t2 = 0; t2 < 4; ++t2) {
                const bf16_t* wp = W2T + (size_t)(16 * t2 + m) * 64 + 32 * s + 4 * q;
                const u32x2 lo = *(const u32x2*)wp, hi = *(const u32x2*)(wp + 16);
                u32x4 aw; aw.x = lo.x; aw.y = lo.y; aw.z = hi.x; aw.w = hi.y;
                d2[t2] = __builtin_amdgcn_mfma_f32_16x16x32_bf16(__builtin_bit_cast(bf16x8, aw), gb, d2[t2], 0, 0, 0);
            }
        }
        bf16_t* KC = (bf16_t*)(ws + WS_KC) + (size_t)t * (NB * 2 * 256 * 64) + (size_t)((b * 2 + g) * 256 + n) * 64;
#pragma unroll
        for (int t2 = 0; t2 < 4; ++t2) {
            u32x2 o; o.x = pk_bf16(d2[t2][0], d2[t2][1]); o.y = pk_bf16(d2[t2][2], d2[t2][3]);
            if (n >= 255) { o.x = 0u; o.y = 0u; }
            *(u32x2*)(KC + 16 * t2 + 4 * q) = o;
        }
    }
    __syncthreads();
}

namespace att {
constexpr int K_BYTES = 8192, V_BYTES = 16384;
constexpr int OFF_RING = 0;
constexpr int OFF_K0 = 0;
constexpr int OFF_WSF = 73728;
constexpr int OFF_IMP = OFF_WSF + NWAVES * 64 * 4;
constexpr int OFF_SELM = OFF_IMP + 4 * 64 * 65 * 4;
constexpr int OFF_END = OFF_SELM + 512;
static_assert(OFF_END <= LDS_BYTES - 256, "attention LDS map");
__device__ __forceinline__ int crow(int r, int hi) { return (r & 3) + 8 * (r >> 2) + 4 * hi; }
typedef short v4i16_t __attribute__((ext_vector_type(4)));
__device__ __forceinline__ s16x4 vtr(const LAS unsigned char* p) { return __builtin_bit_cast(s16x4, __builtin_amdgcn_ds_read_tr16_b64_v4i16((LAS v4i16_t*)p)); }

template <int NDB> struct Stage { u32x4 k; u32x4 v[NDB / 2]; };
template <int NDB>
__device__ __forceinline__ void stage_load(Stage<NDB>& s, const bf16_t* Kg, const bf16_t* Vg, int pitch, int j, int tid) {
    const int key = tid >> 3, ch = tid & 7;
    s.k = *(const u32x4*)(Kg + (size_t)(j * 64 + key) * pitch + ch * 8);
    if constexpr (NDB == 2) { s.v[0] = *(const u32x4*)(Vg + (size_t)(j * 64 + key) * pitch + ch * 8); }
    else {
#pragma unroll
        for (int p = 0; p < 2; ++p) { const int row = p * 32 + (tid >> 4), c16 = tid & 15; s.v[p] = *(const u32x4*)(Vg + (size_t)(j * 64 + row) * pitch + c16 * 8); }
    }
}
template <int NDB>
__device__ __forceinline__ void stage_store(const Stage<NDB>& s, LAS unsigned char* Kb, LAS unsigned char* Vb, int tid) {
    const int key = tid >> 3, ch = tid & 7;
    *(LAS u32x4*)(Kb + ch * 1024 + ((key ^ ch) << 4)) = s.k;
    if constexpr (NDB == 2) { *(LAS u32x4*)(Vb + (ch >> 2) * 4096 + (key >> 4) * 1024 + (key & 15) * 64 + (ch & 3) * 16) = s.v[0]; }
    else {
#pragma unroll
        for (int p = 0; p < 2; ++p) { const int row = p * 32 + (tid >> 4), c16 = tid & 15; *(LAS u32x4*)(Vb + (c16 >> 2) * 4096 + (row >> 4) * 1024 + (row & 15) * 64 + (c16 & 3) * 16) = s.v[p]; }
    }
}
__device__ __forceinline__ void tile_scores(f32x16& p0, f32x16& p1, const LAS unsigned char* Kb, const bf16x8 (&qr)[4], int kvbase, int lob, int hib, int lane) {
    const int r32 = lane & 31, hi = lane >> 5;
    p0 = (f32x16){0.f}; p1 = (f32x16){0.f};
    bf16x8 kf0[4], kf1[4];
#pragma unroll
    for (int d0 = 0; d0 < 4; ++d0) {
        const int c = 2 * d0 + hi;
        const LAS unsigned char* kp = Kb + c * 1024 + ((r32 ^ c) << 4);
        kf0[d0] = *(const LAS bf16x8*)kp; kf1[d0] = *(const LAS bf16x8*)(kp + 512);
    }
    __builtin_amdgcn_sched_barrier(0);
#pragma unroll
    for (int d0 = 0; d0 < 4; ++d0) {
        p0 = __builtin_amdgcn_mfma_f32_32x32x16_bf16(kf0[d0], qr[d0], p0, 0, 0, 0);
        p1 = __builtin_amdgcn_mfma_f32_32x32x16_bf16(kf1[d0], qr[d0], p1, 0, 0, 0);
    }
    const bool allv = (kvbase + 63 <= hib) && (kvbase > lob);
    if (!__all(allv)) {
#pragma unroll
        for (int r = 0; r < 16; ++r) {
            const int kv = kvbase + crow(r, hi);
            if (kv > hib || kv <= lob) p0[r] = -INFINITY;
            if (kv + 32 > hib || kv + 32 <= lob) p1[r] = -INFINITY;
        }
    }
}
__device__ __forceinline__ float max3f(float a, float b, float c) { return __builtin_fmaxf(__builtin_fmaxf(a, b), c); }
__device__ __forceinline__ float rowmax32(const f32x16& p0, const f32x16& p1) {
    float a = max3f(p0[0], p0[1], p1[0]), b = max3f(p0[2], p0[3], p1[1]); a = max3f(a, p1[2], p1[3]);
#pragma unroll
    for (int r = 4; r < 16; r += 4) { a = max3f(a, p0[r], p0[r + 1]); b = max3f(b, p0[r + 2], p0[r + 3]); a = max3f(a, p1[r], p1[r + 1]); b = max3f(b, p1[r + 2], p1[r + 3]); }
    a = __builtin_fmaxf(a, b);
    return __builtin_fmaxf(a, swap32_other(a));
}
template <int NDB>
__device__ __forceinline__ void tile_compute(const LAS unsigned char* Kb, const LAS unsigned char* Vb, const bf16x8 (&qr)[4], float& m, float& l, f32x16 (&o)[NDB], LAS float* wsf, int kvbase, int lob, int hib, int lane, bool lanesel = true) {
    const int hi = lane >> 5, r32 = lane & 31;
    f32x16 p0, p1;
    tile_scores(p0, p1, Kb, qr, kvbase, lob, hib, lane);
    const float rm = lanesel ? rowmax32(p0, p1) : -INFINITY;
    const float mn = fmaxf(m, rm);
    if (__any(mn > m + 8.0f)) {
        const float alpha = __builtin_amdgcn_exp2f(m - mn);
        l *= alpha; m = mn;
        if (hi == 0) wsf[r32] = alpha;
#pragma unroll
        for (int g = 0; g < 4; ++g) {
            const f32x4 a4 = *(const LAS f32x4*)(wsf + 8 * g + 4 * hi);
#pragma unroll
            for (int db = 0; db < NDB; ++db) { o[db][4 * g + 0] *= a4[0]; o[db][4 * g + 1] *= a4[1]; o[db][4 * g + 2] *= a4[2]; o[db][4 * g + 3] *= a4[3]; }
        }
    }
    {
        const float msub = lanesel ? m : INFINITY;
        const f32x2 m2 = {msub, msub};
        f32x2 sa = {0.f, 0.f}, sb = {0.f, 0.f};
#pragma unroll
        for (int r = 0; r < 16; r += 2) {
            f32x2 t0 = (f32x2){p0[r], p0[r + 1]} - m2, t1 = (f32x2){p1[r], p1[r + 1]} - m2;
            t0.x = __builtin_amdgcn_exp2f(t0.x); t0.y = __builtin_amdgcn_exp2f(t0.y); t1.x = __builtin_amdgcn_exp2f(t1.x); t1.y = __builtin_amdgcn_exp2f(t1.y);
            sa += t0; sb += t1;
            p0[r] = t0.x; p0[r + 1] = t0.y; p1[r] = t1.x; p1[r + 1] = t1.y;
        }
        sa += sb;
        l += sa.x + sa.y;
    }
    u32x4 pw[4];
#pragma unroll
    for (int k = 0; k < 2; ++k) {
        pw[k] = (u32x4){pk_bf16(p0[8 * k + 0], p0[8 * k + 1]), pk_bf16(p0[8 * k + 2], p0[8 * k + 3]), pk_bf16(p0[8 * k + 4], p0[8 * k + 5]), pk_bf16(p0[8 * k + 6], p0[8 * k + 7])};
        pw[2 + k] = (u32x4){pk_bf16(p1[8 * k + 0], p1[8 * k + 1]), pk_bf16(p1[8 * k + 2], p1[8 * k + 3]), pk_bf16(p1[8 * k + 4], p1[8 * k + 5]), pk_bf16(p1[8 * k + 6], p1[8 * k + 7])};
    }
    const LAS unsigned char* vp = Vb + ((lane >> 4) & 1) * 32 + (lane & 3) * 8 + (4 * hi + ((lane & 15) >> 2)) * 64;
    s16x4 vlo[2][4], vhh[2][4];
#pragma unroll
    for (int ks = 0; ks < 4; ++ks) { vlo[0][ks] = vtr(vp + ks * 1024); vhh[0][ks] = vtr(vp + ks * 1024 + 512); }
#pragma unroll
    for (int db = 0; db < NDB; ++db) {
        if (NDB == 4 && db + 1 < NDB) {
#pragma unroll
            for (int ks = 0; ks < 4; ++ks) { vlo[(db + 1) & 1][ks] = vtr(vp + (db + 1) * 4096 + ks * 1024); vhh[(db + 1) & 1][ks] = vtr(vp + (db + 1) * 4096 + ks * 1024 + 512); }
        }
        if (NDB != 4 && db > 0) {
#pragma unroll
            for (int ks = 0; ks < 4; ++ks) { vlo[db & 1][ks] = vtr(vp + db * 4096 + ks * 1024); vhh[db & 1][ks] = vtr(vp + db * 4096 + ks * 1024 + 512); }
        }
        __builtin_amdgcn_sched_barrier(0);
#pragma unroll
        for (int ks = 0; ks < 4; ++ks) {
            const s16x4 lo = vlo[db & 1][ks], hh = vhh[db & 1][ks];
            const bf16x8 vf = (bf16x8){lo[0], lo[1], lo[2], lo[3], hh[0], hh[1], hh[2], hh[3]};
            o[db] = __builtin_amdgcn_mfma_f32_32x32x16_bf16(__builtin_bit_cast(bf16x8, pw[ks]), vf, o[db], 0, 0, 0);
        }
        __builtin_amdgcn_sched_barrier(0);
    }
}
__device__ __forceinline__ void glds16(const bf16_t* gsrc, LAS unsigned char* lds_dst) {
    unsigned keep; const unsigned dst = (unsigned)__builtin_amdgcn_readfirstlane((int)(unsigned)(size_t)lds_dst);
    asm volatile("s_mov_b32 %0, m0\n\ts_mov_b32 m0, %2\n\ts_nop 0\n\tglobal_load_lds_dwordx4 %1, off\n\ts_mov_b32 m0, %0" : "=&s"(keep) : "v"(gsrc), "s"(dst) : "memory");
}
#define ATT_WAIT_BAR(N) asm volatile("s_waitcnt vmcnt(" #N ") lgkmcnt(0)\n\ts_barrier" ::: "memory")
template <int NDB, bool SEL>
__device__ __forceinline__ void stream(LAS unsigned char* lds, const bf16_t* Kg, const bf16_t* Vg, int pitch, int ntiles, int j0, unsigned long long tilemask, unsigned long long mymask, int lob, int hib,
                                       const bf16x8 (&qr)[4], float& m, float& l, f32x16 (&o)[NDB], LAS float* wsf, int tid, int lane, int wave) {
    constexpr int SLOT = K_BYTES + NDB * 4096;
    const bf16_t* ksrc = Kg + (size_t)(lane ^ wave) * pitch + wave * 8;
    const bf16_t* vsrc0 = Vg + (size_t)(16 * (wave & 3) + (lane >> 2)) * pitch + (wave >> 2) * 32 + (lane & 3) * 8;
    const size_t tstep = (size_t)64 * pitch;
    auto issue = [&](int j, int slot) {
        LAS unsigned char* base = lds + OFF_RING + slot * SLOT;
        glds16(ksrc + (size_t)j * tstep, base + wave * 1024);
        glds16(vsrc0 + (size_t)j * tstep, base + K_BYTES + wave * 1024);
        if constexpr (NDB == 4) glds16(vsrc0 + (size_t)j * tstep + 64, base + K_BYTES + (wave + 8) * 1024);
    };
    unsigned long long rem = tilemask;
    int jseq = j0;
    auto nextj = [&]() -> int { if constexpr (SEL) { const int j = __ffsll((long long)rem) - 1; rem &= rem - 1; return j; } else { return jseq++; } };
    asm volatile("s_waitcnt vmcnt(0)" ::: "memory");
    int jc = nextj(), jn = 0;
    issue(jc, 0);
    if (ntiles > 1) { jn = nextj(); issue(jn, 1); }
    if (ntiles > 1) { if constexpr (NDB == 4) ATT_WAIT_BAR(3); else ATT_WAIT_BAR(2); } else ATT_WAIT_BAR(0);
    int hib_min = hib;
    if constexpr (SEL) { hib_min = __builtin_amdgcn_readfirstlane(hib - (lane & 31)); }
    int slot = 0;
#pragma nounroll
    for (int i = 0; i < ntiles; ++i) {
        int jn2 = 0;
        const bool more2 = i + 2 < ntiles;
        if (more2) { jn2 = nextj(); issue(jn2, slot == 0 ? 2 : slot - 1); }
        const LAS unsigned char* Kb = lds + OFF_RING + slot * SLOT;
        if constexpr (SEL) {
            const bool sel = ((mymask >> jc) & 1ull) != 0ull;
            if (jc * 64 + 63 <= hib_min) tile_compute<NDB>(Kb, Kb + K_BYTES, qr, m, l, o, wsf, jc * 64, lob, 0x7fffffff, lane, sel);
            else tile_compute<NDB>(Kb, Kb + K_BYTES, qr, m, l, o, wsf, jc * 64, lob, sel ? hib : -1, lane);
        } else {
            tile_compute<NDB>(Kb, Kb + K_BYTES, qr, m, l, o, wsf, jc * 64, lob, hib, lane);
        }
        if (more2) { if constexpr (NDB == 4) ATT_WAIT_BAR(3); else ATT_WAIT_BAR(2); } else ATT_WAIT_BAR(0);
        jc = jn; jn = jn2; slot = slot == 2 ? 0 : slot + 1;
    }
}
template <int NDB>
__device__ __forceinline__ void fold(f32x16 (&acc)[NDB], const f32x16 (&o)[NDB], float coef, LAS float* wsf, int lane, bool first) {
    const int hi = lane >> 5, r32 = lane & 31;
    if (hi == 0) wsf[32 + r32] = coef;
#pragma unroll
    for (int g = 0; g < 4; ++g) {
        const f32x4 c4 = *(const LAS f32x4*)(wsf + 32 + 8 * g + 4 * hi);
#pragma unroll
        for (int db = 0; db < NDB; ++db)
#pragma unroll
            for (int e = 0; e < 4; ++e) acc[db][4 * g + e] = first ? o[db][4 * g + e] * c4[e] : acc[db][4 * g + e] + o[db][4 * g + e] * c4[e];
    }
}
}

__device__ __forceinline__ void da_unit(const Params& P, LAS unsigned char* lds, int b, int h, int qb, int tid, int lane, int wave) {
    asm volatile("" : "+v"(tid), "+v"(lane));
    unsigned char* ws = P.ws;
    const bf16_t* Z = (const bf16_t*)(ws + WS_ZA) + (size_t)b * SEQ * ZP;
    const int r32 = lane & 31, hi = lane >> 5;
    const int q0 = qb * 256, qpos = q0 + wave * 32 + r32;
    LAS float* wsf = (LAS float*)(lds + att::OFF_WSF) + wave * 64;
    const int ntiles = (q0 + 256) / 64;
    unsigned o1p[4][8];
    f32x16 o[4]; float cf[16];
#pragma nounroll
    for (int comp = 0; comp < 2; ++comp) {
        bf16x8 qr[4];
#pragma unroll
        for (int d0 = 0; d0 < 4; ++d0) qr[d0] = *(const bf16x8*)(Z + (size_t)qpos * ZP + ZC_QDA + h * 128 + comp * 64 + d0 * 16 + hi * 8);
        asm volatile("" : "+v"(qr[0]), "+v"(qr[1]), "+v"(qr[2]), "+v"(qr[3]));
        float m = -1e30f, l = 0.f;
#pragma unroll
        for (int i = 0; i < 4; ++i) o[i] = (f32x16){0.f};
        att::stream<4, false>(lds, Z + ZC_KDA + h * 128 + comp * 64, Z + ZC_VDA + h * 128, ZP, ntiles, 0, 0ull, 0ull, -0x7fffffff, qpos, qr, m, l, o, wsf, tid, lane, wave);
        const float lt = l + swap32_other(l);
        const float coef = 1.0f / lt;
        if (hi == 0) wsf[32 + r32] = coef;
#pragma unroll
        for (int g = 0; g < 4; ++g) { const f32x4 c4 = *(const LAS f32x4*)(wsf + 32 + 8 * g + 4 * hi); cf[4 * g] = c4[0]; cf[4 * g + 1] = c4[1]; cf[4 * g + 2] = c4[2]; cf[4 * g + 3] = c4[3]; }
        if (comp == 0) {
#pragma unroll
            for (int db = 0; db < 4; ++db)
#pragma unroll
                for (int r = 0; r < 8; ++r) o1p[db][r] = pk_bf16(o[db][2 * r] * cf[2 * r], o[db][2 * r + 1] * cf[2 * r + 1]);
        }
    }
    const float lam = ((const float*)(ws + WS_MISC))[0];
    const float* subln = P.in[7];
    float sl[4];
#pragma unroll
    for (int db = 0; db < 4; ++db) sl[db] = subln[32 * db + r32] * (1.0f - LAMBDA_INIT);
    bf16_t* Y = (bf16_t*)(ws + WS_Y) + (size_t)(b * SEQ + q0 + wave * 32 + 4 * hi) * 1024 + h * 128 + r32;
    asm volatile("" : "+v"(Y));
#pragma unroll
    for (int r = 0; r < 16; ++r) {
        float v[4];
#pragma unroll
        for (int db = 0; db < 4; ++db) v[db] = ((r & 1) ? bf_hi(o1p[db][r >> 1]) : bf_lo(o1p[db][r >> 1])) - lam * o[db][r] * cf[r];
        float s = v[0] * v[0] + v[1] * v[1] + v[2] * v[2] + v[3] * v[3];
        s = row16_sum(s); s += swz16f(s);
        const float rs = rsqrtf(s * (1.0f / 128.0f) + RMS_EPS);
        const int qrow = (r & 3) + 8 * (r >> 2);
#pragma unroll
        for (int db = 0; db < 4; ++db) ((__attribute__((address_space(1))) bf16_t*)Y)[(size_t)qrow * 1024 + 32 * db] = (bf16_t)(pk_bf16(v[db] * rs * sl[db], 0.f) & 0xffffu);
    }
}

__device__ __forceinline__ void nsa_unit(const Params& P, LAS unsigned char* lds, int b, int g, int ib, int tid, int lane, int wave) {
    asm volatile("" : "+v"(tid), "+v"(lane));
    unsigned char* ws = P.ws;
    const bf16_t* Z = (const bf16_t*)(ws + WS_ZA) + (size_t)b * SEQ * ZP;
    const int r32 = lane & 31, hi = lane >> 5;
    const int hh = wave >> 1, head = g * 4 + hh, ql = (wave & 1) * 32 + r32, qpos = ib * 64 + ql;
    LAS float* wsf = (LAS float*)(lds + att::OFF_WSF) + wave * 64;
    LAS float* imp = (LAS float*)(lds + att::OFF_IMP);
    LAS unsigned long long* selm = (LAS unsigned long long*)(lds + att::OFF_SELM);
    const float* gn = (const float*)(ws + WS_GN) + (size_t)(b * SEQ + qpos) * 32 + head * 3;
    float g0 = gn[0], g1 = gn[1], g2 = gn[2];
    asm volatile("" : "+v"(g0), "+v"(g1), "+v"(g2));
    bf16x8 qr[4];
#pragma unroll
    for (int d0 = 0; d0 < 4; ++d0) qr[d0] = *(const bf16x8*)(Z + (size_t)qpos * ZP + ZC_QN + head * 64 + d0 * 16 + hi * 8);
    asm volatile("" : "+v"(qr[0]), "+v"(qr[1]), "+v"(qr[2]), "+v"(qr[3]));
    for (int i = tid; i < 4 * 64 * 65; i += 512) imp[i] = 0.f;
    f32x16 res[2];
    const bf16_t* KC = (const bf16_t*)(ws + WS_KC) + (size_t)((b * 2 + g) * 256) * 64;
    const bf16_t* VC = KC + (size_t)NB * 2 * 256 * 64;
    const int nmax = qpos >= 31 ? (((qpos - 31) >> 4) < 254 ? ((qpos - 31) >> 4) : 254) : -1;
    const int ntc = ((4 * ib + 2) >> 6) + 1;
    float mc, invl;
    {
        float m = -1e30f, l = 0.f; f32x16 o[2]; o[0] = (f32x16){0.f}; o[1] = (f32x16){0.f};
        att::stream<2, false>(lds, KC, VC, 64, ntc, 0, 0ull, 0ull, -0x7fffffff, nmax, qr, m, l, o, wsf, tid, lane, wave);
        const float lt = l + swap32_other(l);
        invl = lt > 0.f ? 1.0f / lt : 0.f; mc = m;
        att::fold<2>(res, o, g0 * invl, wsf, lane, true);
    }
    {
        float carry = 0.f;
        att::Stage<2> st;
        for (int jt = 0; jt < ntc; ++jt) {
            st.k = *(const u32x4*)(KC + (size_t)(jt * 64 + (tid >> 3)) * 64 + (tid & 7) * 8);
            { const int key = tid >> 3, ch = tid & 7; *(LAS u32x4*)(lds + att::OFF_K0 + ch * 1024 + ((key ^ ch) << 4)) = st.k; }
            __syncthreads();
            f32x16 p0, p1;
            att::tile_scores(p0, p1, lds + att::OFF_K0, qr, jt * 64, -0x7fffffff, nmax, lane);
            float G[8], E[8];
#pragma unroll
            for (int kk = 0; kk < 4; ++kk) {
                float a0 = __builtin_amdgcn_exp2f(p0[4 * kk + 0] - mc) * invl, a1 = __builtin_amdgcn_exp2f(p0[4 * kk + 1] - mc) * invl, a2 = __builtin_amdgcn_exp2f(p0[4 * kk + 2] - mc) * invl, a3 = __builtin_amdgcn_exp2f(p0[4 * kk + 3] - mc) * invl;
                G[kk] = (a0 + a1) + (a2 + a3); E[kk] = a3;
                float b0 = __builtin_amdgcn_exp2f(p1[4 * kk + 0] - mc) * invl, b1 = __builtin_amdgcn_exp2f(p1[4 * kk + 1] - mc) * invl, b2 = __builtin_amdgcn_exp2f(p1[4 * kk + 2] - mc) * invl, b3 = __builtin_amdgcn_exp2f(p1[4 * kk + 3] - mc) * invl;
                G[4 + kk] = (b0 + b1) + (b2 + b3); E[4 + kk] = b3;
            }
            float X[8];
#pragma unroll
            for (int kk = 0; kk < 8; ++kk) X[kk] = swap32_other(E[kk]);
#pragma unroll
            for (int kk = 0; kk < 8; ++kk) {
                const float prev = hi ? X[kk] : (kk == 0 ? carry : X[kk - 1]);
                const int s = 16 * jt + 2 * kk + hi;
                imp[(hh * 64 + s) * 65 + ql] = G[kk] + prev;
            }
            carry = X[7];
            __syncthreads();
        }
    }
    __syncthreads();
    {
        const int s = lane;
        const bool valid = s <= ib, forced = (s == 0) || (s == ib) || (s == ib - 1);
#pragma nounroll
        for (int qq = 0; qq < 8; ++qq) {
            const int q = wave * 8 + qq;
            const float v = imp[(0 * 64 + s) * 65 + q] + imp[(1 * 64 + s) * 65 + q] + imp[(2 * 64 + s) * 65 + q] + imp[(3 * 64 + s) * 65 + q];
            bool sel;
            if (ib + 1 <= 16) sel = valid;
            else {
                const bool cand = valid && !forced;
                const unsigned key = cand ? (((__float_as_uint(v) & ~63u) + 64u) | (unsigned)(63 - s)) : 0u;
                LAS unsigned* wsu = (LAS unsigned*)wsf;
                wsu[s] = key;
                int rank = 0;
#pragma unroll
                for (int s4 = 0; s4 < 16; ++s4) {
                    const u32x4 k4 = *(const LAS u32x4*)(wsu + 4 * s4);
#pragma unroll
                    for (int e = 0; e < 4; ++e) rank += (k4[e] > key) ? 1 : 0;
                }
                sel = forced || (cand && rank < 13);
            }
            const unsigned long long mk = __ballot(sel);
            if (lane == 0) selm[q] = mk;
        }
    }
    __syncthreads();
    const unsigned long long mymask = selm[ql];
    unsigned long long uni = 0ull;
    for (int q = 0; q < 64; ++q) uni |= selm[q];
    uni = ((unsigned long long)(unsigned)__builtin_amdgcn_readfirstlane((int)(uni >> 32)) << 32) | (unsigned)__builtin_amdgcn_readfirstlane((int)(uni & 0xffffffffull));
    {
        float m = -1e30f, l = 0.f; f32x16 o[2]; o[0] = (f32x16){0.f}; o[1] = (f32x16){0.f};
        const int nts = __popcll(uni);
        att::stream<2, true>(lds, Z + ZC_KS + g * 64, Z + ZC_VS + g * 64, ZP, nts, 0, uni, mymask, -0x7fffffff, qpos, qr, m, l, o, wsf, tid, lane, wave);
        const float lt = l + swap32_other(l);
        att::fold<2>(res, o, lt > 0.f ? g1 / lt : 0.f, wsf, lane, false);
    }
    {
        float m = -1e30f, l = 0.f; f32x16 o[2]; o[0] = (f32x16){0.f}; o[1] = (f32x16){0.f};
        const int j0 = ib >= 8 ? ib - 8 : 0;
        att::stream<2, false>(lds, Z + ZC_KW + g * 64, Z + ZC_VW + g * 64, ZP, ib - j0 + 1, j0, 0ull, 0ull, qpos - 512, qpos, qr, m, l, o, wsf, tid, lane, wave);
        const float lt = l + swap32_other(l);
        att::fold<2>(res, o, lt > 0.f ? g2 / lt : 0.f, wsf, lane, false);
    }
    bf16_t* Y = (bf16_t*)(ws + WS_Y) + (size_t)(b * SEQ + ib * 64 + (wave & 1) * 32 + 4 * hi) * 1024 + 512 + head * 64 + r32;
    asm volatile("" : "+v"(Y));
#pragma unroll
    for (int r = 0; r < 16; ++r) {
        const int qrow = (r & 3) + 8 * (r >> 2);
#pragma unroll
        for (int db = 0; db < 2; ++db) ((__attribute__((address_space(1))) bf16_t*)Y)[(size_t)qrow * 1024 + 32 * db] = (bf16_t)(pk_bf16(res[db][r], 0.f) & 0xffffu);
    }
    __syncthreads();
}

__device__ __forceinline__ void cswap_desc(unsigned& a, unsigned& b) { const unsigned hi = a > b ? a : b, lo = a > b ? b : a; a = hi; b = lo; }
__device__ __forceinline__ unsigned f16_order(unsigned hb) { return (hb & 0x8000u) ? (~hb & 0xffffu) : (hb | 0x8000u); }
__device__ __forceinline__ float f16_unorder(unsigned ob) { const unsigned hb = (ob & 0x8000u) ? (ob & 0x7fffu) : (~ob & 0xffffu); return (float)__builtin_bit_cast(_Float16, (unsigned short)hb); }
__device__ __forceinline__ unsigned f32_order(float f) { const unsigned u = __float_as_uint(f); return (u & 0x80000000u) ? ~u : (u | 0x80000000u); }

__device__ __forceinline__ void peer_issue(u32x4 (&uv)[16], float& su, float& sv, const unsigned char* UVb, const float* TSC, const LAS unsigned* tabE, int bt, int myslot, unsigned lane16) {
#pragma unroll
    for (int e = 0; e < 16; ++e) { const unsigned off = tabE[bt * 16 + e] + lane16; uv[e] = *(const u32x4*)(UVb + off); }
    const unsigned myidx = tabE[bt * 16 + myslot] >> 10;
    su = TSC[myidx]; sv = TSC[NEXP + myidx];
}
__device__ __forceinline__ float peer_dot(const u32x4 (&uv)[16], float su, float sv, const int (&cH)[2], const int (&cL)[2], float chalf, float rsc, const LAS float* tabG, int bt, int myslot, int lane) {
    float part[16];
#pragma unroll
    for (int e = 0; e < 16; ++e) {
        int ah = __builtin_amdgcn_sdot8((int)uv[e][0], cH[0], 0, false); ah = __builtin_amdgcn_sdot8((int)uv[e][1], cH[1], ah, false);
        int al = __builtin_amdgcn_sdot8((int)uv[e][0], cL[0], 0, false); al = __builtin_amdgcn_sdot8((int)uv[e][1], cL[1], al, false);
        part[e] = (float)(ah * 16 + al);
    }
    float r8[8];
#pragma unroll
    for (int e = 0; e < 8; ++e) {
        auto rr = __builtin_amdgcn_permlane32_swap(__float_as_uint(part[e]), __float_as_uint(part[e + 8]), false, false);
        r8[e] = __uint_as_float(rr[0]) + __uint_as_float(rr[1]);
    }
    const bool b4 = (lane & 16) != 0, b3 = (lane & 8) != 0, b2 = (lane & 4) != 0;
    float r4[4];
#pragma unroll
    for (int e = 0; e < 4; ++e) { const float send = b4 ? r8[e] : r8[e + 4], keep = b4 ? r8[e + 4] : r8[e]; r4[e] = keep + swz16f(send); }
    float r2[2];
#pragma unroll
    for (int e = 0; e < 2; ++e) { const float send = b3 ? r4[e] : r4[e + 2], keep = b3 ? r4[e + 2] : r4[e]; r2[e] = keep + dppf<DPP_ROR8>(send); }
    float r1;
    { const float send = b2 ? r2[0] : r2[1], keep = b2 ? r2[1] : r2[0]; r1 = keep + dppf<DPP_HMIRROR>(send); }
    r1 += dppf<DPP_XOR1>(r1); r1 += dppf<DPP_XOR2>(r1);
    return gelu_poly((r1 + chalf) * rsc * su) * tabG[bt * 16 + myslot] * sv;
}
__device__ __forceinline__ void peer_vphase(const u32x4 (&uv)[16], float hval, f32x4 (&acc)[4]) {
#pragma unroll
    for (int e = 0; e < 16; ++e) {
        const float w = __int_as_float(__builtin_amdgcn_readlane(__float_as_int(hval), e * 4));
        const f32x2 w2 = {w, w};
#pragma unroll
        for (int h = 0; h < 2; ++h) {
            const f32x2 p0 = __builtin_amdgcn_cvt_scalef32_pk_f32_fp4(uv[e][2 + h], 1.0f, 0), p1 = __builtin_amdgcn_cvt_scalef32_pk_f32_fp4(uv[e][2 + h], 1.0f, 1);
            const f32x2 p2 = __builtin_amdgcn_cvt_scalef32_pk_f32_fp4(uv[e][2 + h], 1.0f, 2), p3 = __builtin_amdgcn_cvt_scalef32_pk_f32_fp4(uv[e][2 + h], 1.0f, 3);
            f32x2 a0 = {acc[2 * h][0], acc[2 * h][1]}, a1 = {acc[2 * h][2], acc[2 * h][3]}, a2 = {acc[2 * h + 1][0], acc[2 * h + 1][1]}, a3 = {acc[2 * h + 1][2], acc[2 * h + 1][3]};
            a0 += w2 * p0; a1 += w2 * p1; a2 += w2 * p2; a3 += w2 * p3;
            acc[2 * h] = (f32x4){a0.x, a0.y, a1.x, a1.y}; acc[2 * h + 1] = (f32x4){a2.x, a2.y, a3.x, a3.y};
        }
    }
}
__device__ __forceinline__ void peer_retrieve_chunk(const unsigned short* SC, LAS unsigned* tabE, LAS float* tabG, int g, int lane) {
    const int row = lane >> 4, j = lane & 15;
    {
        const u32x4 raw = *(const u32x4*)(SC + g * 512 + lane * 8);
        unsigned k[8];
#pragma unroll
        for (int e = 0; e < 4; ++e) {
            const unsigned w = raw[e];
            k[2 * e] = (f16_order(w & 0xffffu) << 16) | (unsigned)(127 - (8 * j + 2 * e));
            k[2 * e + 1] = (f16_order(w >> 16) << 16) | (unsigned)(127 - (8 * j + 2 * e + 1));
        }
        cswap_desc(k[0], k[1]); cswap_desc(k[2], k[3]); cswap_desc(k[4], k[5]); cswap_desc(k[6], k[7]);
        cswap_desc(k[0], k[2]); cswap_desc(k[1], k[3]); cswap_desc(k[4], k[6]); cswap_desc(k[5], k[7]);
        cswap_desc(k[1], k[2]); cswap_desc(k[5], k[6]); cswap_desc(k[0], k[4]); cswap_desc(k[3], k[7]);
        cswap_desc(k[1], k[5]); cswap_desc(k[2], k[6]);
        cswap_desc(k[1], k[4]); cswap_desc(k[3], k[6]);
        cswap_desc(k[2], k[4]); cswap_desc(k[3], k[5]);
        cswap_desc(k[3], k[4]);
        unsigned mine = 0u;
#pragma unroll
        for (int it = 0; it < 16; ++it) {
            const unsigned w = row16_maxu(k[0]);
            if (k[0] == w) { k[0] = k[1]; k[1] = k[2]; k[2] = k[3]; k[3] = k[4]; k[4] = k[5]; k[5] = k[6]; k[6] = k[7]; k[7] = 0u; }
            mine = (j == it) ? w : mine;
        }
        const int hl = row >> 1, c = row & 1;
        static constexpr unsigned PTAB[32] = {0x31000u, 0x33020u, 0x35040u, 0x37060u, 0x39080u, 0x3b0a0u, 0x3d0c0u, 0x3f0e0u, 0x31101u, 0x33121u, 0x35141u, 0x37161u, 0x31202u, 0x33222u, 0x20042u, 0x31303u, 0x33323u, 0x31404u, 0x20024u, 0x31505u, 0x31606u, 0x31707u, 0x30908u, 0x30b0au, 0x30d0cu, 0x30f0eu, 0x00000u, 0x00000u, 0x00000u, 0x00000u, 0x00000u, 0x00000u};
        const unsigned te = PTAB[(row & 1) * 16 + j];
        const int a0 = te & 15, b0 = (te >> 4) & 15, a1 = (te >> 8) & 15, b1 = (te >> 12) & 15;
        const int base1 = (2 * hl) * 16, base2 = (2 * hl + 1) * 16;
        const unsigned k1a = (unsigned)__shfl((int)mine, base1 + a0), k2a = (unsigned)__shfl((int)mine, base2 + b0);
        const unsigned k1b = (unsigned)__shfl((int)mine, base1 + a1), k2b = (unsigned)__shfl((int)mine, base2 + b1);
        const float s0 = f16_unorder(k1a >> 16) + f16_unorder(k2a >> 16), s1 = f16_unorder(k1b >> 16) + f16_unorder(k2b >> 16);
        unsigned ck0 = ((te >> 17) & 1u) ? ((f32_order(s0) & 0xffffff00u) | (unsigned)(255 - (a0 * 16 + b0))) : 0u;
        unsigned ck1 = ((te >> 16) & 1u) ? ((f32_order(s1) & 0xffffff00u) | (unsigned)(255 - (a1 * 16 + b1))) : 0u;
        unsigned mine2 = 0u;
#pragma unroll
        for (int it = 0; it < 16; ++it) {
            unsigned w = row16_maxu(ck0);
            const unsigned w2 = swz16u(w); w = w > w2 ? w : w2;
            if (ck0 == w) { ck0 = ck1; ck1 = 0u; }
            mine2 = (j == it) ? w : mine2;
        }
        const int flat = 255 - (int)(mine2 & 0xffu), a = flat >> 4, bb = flat & 15;
        const unsigned ka = (unsigned)__shfl((int)mine, (2 * hl) * 16 + a), kb = (unsigned)__shfl((int)mine, (2 * hl + 1) * 16 + bb);
        const float sc = f16_unorder(ka >> 16) + f16_unorder(kb >> 16);
        const int i1 = 127 - (int)(ka & 0xffffu), i2 = 127 - (int)(kb & 0xffffu);
        const float smax = __shfl(sc, (lane & 48));
        const float ex = __expf(sc - smax);
        const float den = row16_sum(ex);
        if (c == 0) { const int slot = (2 * g + hl) * 16 + j; tabE[slot] = (unsigned)(i1 * 128 + i2) << 10; tabG[slot] = ex * __builtin_amdgcn_rcpf(den); }
    }
}
__device__ __forceinline__ void peer_phase(const Params& P, LAS unsigned char* lds, int gw, int NGW, int wave, int lane, bool alt) {
    unsigned char* ws = P.ws;
    LAS unsigned* tabs = (LAS unsigned*)(lds + wave * 16384);
    const int ntok = (NT - gw + NGW - 1) / NGW;
#if ENABLE_PEER
#pragma nounroll
    for (int g = 0; g < 4; ++g) peer_retrieve_chunk((const unsigned short*)(ws + WS_SC) + (size_t)gw * 2048, tabs, (LAS float*)(tabs + 128), g, lane);
    const unsigned char* UVb = (const unsigned char*)(ws + WS_UT);
    const float* TSC = (const float*)(ws + WS_TSC);
    const int myslot = (lane >> 2) & 15;
#endif
#pragma nounroll
    for (int k0 = 0; k0 < (ntok < 16 ? ntok : 16) * (PROBE_P7 == 2 ? 2 : 1); ++k0) {
        const int k = k0 & 15;
        const bool dummy = alt;
        const int t = gw + k * NGW;
        float* hrow = P.out + (size_t)t * DM;
        f32x4 acc[4];
#pragma unroll
        for (int i = 0; i < 4; ++i) acc[i] = (f32x4){0.f, 0.f, 0.f, 0.f};
        float hres[16];
        { const bf16_t* HBr = (const bf16_t*)(ws + WS_HG) + (size_t)t * DM; const u32x4 ca = *(const u32x4*)(HBr + lane * 16), cb = *(const u32x4*)(HBr + lane * 16 + 8);
#pragma unroll
          for (int i = 0; i < 4; ++i) { hres[2 * i] = bf_lo(ca[i]); hres[2 * i + 1] = bf_hi(ca[i]); hres[8 + 2 * i] = bf_lo(cb[i]); hres[8 + 2 * i + 1] = bf_hi(cb[i]); } }
#if ENABLE_PEER
        const LAS unsigned* tabE = tabs + k * 256; const LAS float* tabG = (const LAS float*)(tabE + 128);
        const float rs = rsqrtf(((const float*)(ws + WS_SS))[t] * (1.0f / DM) + RMS_EPS);
        int cH[2], cL[2]; float chalf, rsc;
        {
            float am = 0.f;
#pragma unroll
            for (int i = 0; i < 16; ++i) am = fmaxf(am, fabsf(hres[i]));
            am = wave_max(am);
            const float s_c = am * (1.0f / 119.0f) + 1e-30f, inv_c = 1.0f / s_c;
            int csum = 0;
#pragma unroll
            for (int h2 = 0; h2 < 2; ++h2) {
                unsigned wh = 0u, wl = 0u;
#pragma unroll
                for (int i = 0; i < 8; ++i) {
                    const int C = (int)rintf(hres[8 * h2 + i] * inv_c);
                    const int H = (C + 8) >> 4, L = C - 16 * H;
                    wh |= ((unsigned)H & 15u) << (4 * i); wl |= ((unsigned)L & 15u) << (4 * i);
                    csum += C;
                }
                cH[h2] = (int)wh; cL[h2] = (int)wl;
            }
            chalf = 0.5f * wave_sum((float)csum);
            rsc = rs * s_c;
        }
#pragma nounroll
        for (int bt = 0; bt < 8; ++bt) {
            u32x4 uv[16]; float su, sv;
            peer_issue(uv, su, sv, UVb, TSC, tabE, bt, myslot, (unsigned)lane * 16u);
            if (!(bt & 1) && k0 + 1 < (ntok < 16 ? ntok : 16))
                peer_retrieve_chunk((const unsigned short*)(ws + WS_SC) + (size_t)(t + NGW) * 2048, tabs + (k + 1) * 256, (LAS float*)(tabs + (k + 1) * 256 + 128), bt >> 1, lane);
            const float hval = peer_dot(uv, su, sv, cH, cL, chalf, rsc, tabG, bt, myslot, lane);
            peer_vphase(uv, hval, acc);
        }
#endif
        const float* fn = P.in[23];
        f32x4 y[4];
#pragma unroll
        for (int i = 0; i < 4; ++i) y[i] = (f32x4){hres[4 * i], hres[4 * i + 1], hres[4 * i + 2], hres[4 * i + 3]} + acc[i];
        float s = 0.f;
#pragma unroll
        for (int i = 0; i < 4; ++i) s += (y[i][0] * y[i][0] + y[i][1] * y[i][1]) + (y[i][2] * y[i][2] + y[i][3] * y[i][3]);
        const float rsf = rsqrtf(wave_sum(s) * (1.0f / DM) + RMS_EPS);
        float* orow = dummy ? (float*)(ws + 96 * MiB) + (size_t)t * 512 - lane * 0 : hrow;
        if (!dummy || lane < 32) {
#pragma unroll
            for (int i = 0; i < 4; ++i) *(f32x4*)(orow + lane * 16 + 4 * i) = y[i] * rsf * *(const f32x4*)(fn + lane * 16 + 4 * i);
        }
    }
}

typedef __attribute__((address_space(1))) unsigned gu32;
#define XB_TMO      128
#define XB_XCNT(j)  (256  + 64 * (j))
#define XB_XSUB(j)  (1280 + 64 * (j))
#define XB_XGEN(j)  (2304 + 64 * (j))
#define XB_TOP      3328
#define XB_TOPGEN   3392
#define XCD_BAR_WORDS 3456
#define XB_SPIN_CAP (1u << 18)

__device__ __forceinline__ unsigned xb_ld(unsigned* p)              { return __hip_atomic_load(p, __ATOMIC_RELAXED, __HIP_MEMORY_SCOPE_AGENT); }
__device__ __forceinline__ unsigned xb_add(unsigned* p, unsigned v) { return __hip_atomic_fetch_add(p, v, __ATOMIC_RELAXED, __HIP_MEMORY_SCOPE_AGENT); }
__device__ __forceinline__ unsigned xb_xcc_id() { return (unsigned)__builtin_amdgcn_s_getreg((3 << 11) | 20) & 0xFu; }
#define XB_SPIN(cond, bar) do { unsigned _sp = 0; while (cond) { __builtin_amdgcn_s_sleep(1); \
    if ((++_sp & 255u) == 0u) { if (xb_ld(&(bar)[XB_TMO])) break; if (_sp > XB_SPIN_CAP) { atomicAdd(&(bar)[XB_TMO], 1u); break; } } } } while (0)

struct XcdBarrier {
    unsigned* bar; unsigned x;
    volatile LAS unsigned* st;
};

__device__ __forceinline__ XcdBarrier xcd_barrier_post(unsigned* bar, volatile LAS unsigned* st) {
    XcdBarrier b; b.bar = bar; b.x = xb_xcc_id(); b.st = st;
    if (threadIdx.x == 0) (void)xb_add(&bar[XB_XCNT(b.x)], 1u);
    return b;
}
__device__ __forceinline__ void xcd_barrier_complete(unsigned* bar, unsigned x, unsigned& nloc, unsigned& nx) {
    const unsigned G = gridDim.x * gridDim.y * gridDim.z;
    unsigned sum, cnt, mine, sp = 0u;
    for (;;) {
        sum = 0u; cnt = 0u; mine = 0u;
#pragma unroll
        for (unsigned j = 0; j < 16; ++j) { const unsigned c = xb_ld(&bar[XB_XCNT(j)]); sum += c; cnt += (c > 0u) ? 1u : 0u; mine = (j == x) ? c : mine; }
        if (sum == G) break;
        __builtin_amdgcn_s_sleep(1);
        if ((++sp & 255u) == 0u) { if (xb_ld(&bar[XB_TMO])) break; if (sp > XB_SPIN_CAP) { atomicAdd(&bar[XB_TMO], 1u); break; } }
    }
    nloc = mine > 0u ? mine : 1u; nx = cnt > 0u ? cnt : 1u;
}

__device__ __forceinline__ void xcd_barrier(const XcdBarrier& b) {
    asm volatile("s_waitcnt vmcnt(0)" ::: "memory");
    __syncthreads();
    if (threadIdx.x == 0) {
        unsigned* bar = b.bar;
        __builtin_amdgcn_s_waitcnt(0);
        unsigned nloc = b.st[0], nx = b.st[1];
        if (nloc == 0u) { xcd_barrier_complete(bar, b.x, nloc, nx); b.st[0] = nloc; b.st[1] = nx; }
        const unsigned old = xb_add(&bar[XB_XSUB(b.x)], 1u);
        const unsigned gen = old / nloc;
        if (old + 1u == (gen + 1u) * nloc) {
            __builtin_amdgcn_fence(__ATOMIC_RELEASE, "agent");
            asm volatile("s_waitcnt vmcnt(0)" ::: "memory");
            const unsigned og = xb_add(&bar[XB_TOP], 1u);
            const unsigned tg = og / nx;
            if (og + 1u == (tg + 1u) * nx) xb_add(&bar[XB_TOPGEN], 1u);
            else XB_SPIN(xb_ld(&bar[XB_TOPGEN]) == tg, bar);
            __builtin_amdgcn_fence(__ATOMIC_ACQUIRE, "agent");
            xb_add(&bar[XB_XGEN(b.x)], 1u);
            asm volatile("s_waitcnt vmcnt(0)" ::: "memory");
        } else {
            XB_SPIN(xb_ld(&bar[XB_XGEN(b.x)]) == gen, bar);
            __builtin_amdgcn_fence(__ATOMIC_ACQUIRE, "agent");
            asm volatile("s_waitcnt vmcnt(0)" ::: "memory");
        }
    }
    __syncthreads();
}

__global__ void __launch_bounds__(NWAVES * 64, 2) mega_fwd(Params P) {
    extern __shared__ __attribute__((aligned(16))) unsigned char lds_raw[];
    LAS unsigned char* lds = (LAS unsigned char*)lds_raw;
    const int tid = threadIdx.x, lane = tid & 63, wave = __builtin_amdgcn_readfirstlane(tid >> 6);
    const int G = gridDim.x, bx = blockIdx.x;
    const int vcu = (G % 8 == 0) ? (bx % 8) * (G / 8) + bx / 8 : bx;
    const int gw = vcu * NWAVES + wave, NGW = G * NWAVES;
    unsigned char* ws = P.ws;
    const int lo = P.ph_lo, hi = P.ph_hi;
#ifndef PH_MASK
#define PH_MASK 0xff
#endif
#define IN_PH(k) (((PH_MASK >> (k)) & 1) && lo <= (k) && (k) < hi)
    volatile LAS unsigned* bst = (volatile LAS unsigned*)(lds + LDS_BYTES - 64);
    if (tid < 2) bst[tid] = 0u;
    __syncthreads();
    XcdBarrier xbar = xcd_barrier_post((unsigned*)(ws + WS_BAR), bst);
#if USE_XCD_BARRIER
#define SEAM(k) do { if (IN_PH(k) && IN_PH((k) + 1)) { xcd_barrier(xbar); } } while (0)
    if (P.ph_lo < 0) cg::this_grid().sync();
#else
#define SEAM(k) do { if (IN_PH(k) && IN_PH((k) + 1)) { cg::this_grid().sync(); } } while (0)
#endif

    if (IN_PH(0)) { p0_prep(P, lds, gw, NGW, wave, lane, 0); xcd_barrier(xbar); p0_prep(P, lds, gw, NGW, wave, lane, 1); }
    SEAM(0);
    if (IN_PH(1)) {
        pg8::Gemm g{(const bf16_t*)(ws + WS_A), (const bf16_t*)(ws + WS_WIN_T), NT, NPAD, DM / 2};
        pg8::StaticOrder S; S.init(NT, NPAD, G, bx);
        EpiInProj E{(bf16_t*)(ws + WS_ZA), (bf16_t*)(ws + WS_GM), (float*)(ws + WS_GN), (const float*)(ws + WS_ROPE), P.alt, (const float*)(ws + WS_ASC), (const float*)(ws + WS_WSC)};
        pg8::gemm_phase<EpiInProj, pg8::StaticOrder, true, true, true>(lds, g, S, E);
    }
    SEAM(1);
    if (IN_PH(2)) {
        for (int w = vcu; w < 256; w += G) compress_tasks(P, lds, w, wave, lane);
        for (int w0 = vcu; w0 < 256 * (1 + ((REPEAT_PH >> 2) & 1)); w0 += G) {
            const int w = w0 & 255;
            const int bh = w >> 3, s = w & 7;
#pragma nounroll
            for (int u = 0; u < 2; ++u) da_unit(P, lds, bh >> 2, bh & 3, u == 0 ? 15 - s : s, tid, lane, wave);
        }
    }
    SEAM(2);
    if (IN_PH(3)) {
#if ENABLE_NSA
        for (int w0 = vcu; w0 < 256 * (1 + ((REPEAT_PH >> 3) & 1)); w0 += G) {
            const int w = w0 & 255;
            const int bg = w >> 4, s = w & 15;
#pragma nounroll
            for (int u = 0; u < 4; ++u) nsa_unit(P, lds, bg >> 1, bg & 1, u == 0 ? 63 - s : (u == 1 ? 47 - s : (u == 2 ? 16 + s : s)), tid, lane, wave);
        }
#else
        { u32x4* z = (u32x4*)(ws + WS_YN); const size_t n16 = (size_t)NT * 512 * 2 / 16;
          for (size_t i = (size_t)gw * 64 + lane; i < n16; i += (size_t)NGW * 64) z[i] = (u32x4){0u, 0u, 0u, 0u}; }
#endif
    }
    SEAM(3);
    if (IN_PH(4)) {
        pg8::Gemm g{(const bf16_t*)(ws + WS_Y), (const bf16_t*)(ws + WS_PDA_T), NT, DM, DM};
        pg8::StaticOrder S; S.init(NT, DM, G, bx);
        EpiMerge E{(const unsigned char*)(ws + WS_GM), (bf16_t*)(ws + WS_MERGED)};
        pg8::gemm_phase<EpiMerge, pg8::StaticOrder, true, true>(lds, g, S, E);
    }
    SEAM(4);
    if (IN_PH(5)) {
        pg8::Gemm g{(const bf16_t*)(ws + WS_MERGED), (const bf16_t*)(ws + WS_WO_T), NT, DM, DM};
        pg8::StaticOrder S; S.init(NT, DM, G, bx);
        EpiWo E{P.in[0], (bf16_t*)(ws + WS_HG), (float*)(ws + (P.alt ? WS_SS + 512 * 1024 : WS_SS))};
        pg8::gemm_phase<EpiWo, pg8::StaticOrder, true, true>(lds, g, S, E);
    }
    SEAM(5);
    if (IN_PH(6)) {
#if ENABLE_PEER
        pg8::Gemm g{(const bf16_t*)(ws + WS_HG), (const bf16_t*)(ws + WS_WP_T), NT, 2048, DM};
        TableOrder S; S.init(NT, 2048, G, bx); S.P = &P; S.gw = gw; S.calls = 0;
        EpiScores E{(const float*)(ws + WS_SS), (unsigned short*)(ws + WS_SC)};
        pg8::gemm_phase<EpiScores, TableOrder, true, true>(lds, g, S, E);
        for (int c = S.calls; c < 4; ++c) convert_table_rows<4>(P, (gw * 4 + c) * 4, lane);
#endif
    }
    SEAM(6);
    if (IN_PH(7)) {
        peer_phase(P, lds, gw, NGW, wave, lane, P.alt != 0);
    }
#if UBENCH
    {
        unsigned x[8]; f32x2 a[8];
#pragma unroll
        for (int i = 0; i < 8; ++i) { x[i] = (unsigned)(tid * 2654435761u + i * 40503u); a[i] = (f32x2){(float)i, 1.0f}; }
#pragma nounroll
        for (int it = 0; it < 4096; ++it) {
#pragma unroll
            for (int i = 0; i < 8; ++i) {
#if UBENCH == 1
                const f32x2 p = __builtin_amdgcn_cvt_scalef32_pk_f32_fp4(x[i], 1.0f, 0), q = __builtin_amdgcn_cvt_scalef32_pk_f32_fp4(x[i], 1.0f, 1);
                x[i] = x[i] * 5u + __float_as_uint(p.x + q.y);
#elif UBENCH == 2
                a[i] = a[i] * (f32x2){1.0001f, 0.9999f} + (f32x2){0.5f, 0.25f}; a[i] = a[i] * (f32x2){0.9999f, 1.0001f} + (f32x2){0.25f, 0.5f};
#elif UBENCH == 3
                const f32x2 p = __builtin_amdgcn_cvt_pk_f32_fp8((int)x[i], false), q = __builtin_amdgcn_cvt_pk_f32_fp8((int)x[i], true);
                x[i] = x[i] * 5u + __float_as_uint(p.x + q.y);
#elif UBENCH == 5
                x[i] = x[i] * 5u + __float_as_uint(__builtin_amdgcn_exp2f(__uint_as_float(x[i] & 0xbfffffffu)) + __builtin_amdgcn_exp2f(__uint_as_float((x[i] >> 1) & 0xbfffffffu)));
#elif UBENCH == 6
                x[i] = (unsigned)__builtin_amdgcn_sdot8((int)x[i], (int)(x[i] >> 3), (int)x[i], false); x[i] = (unsigned)__builtin_amdgcn_sdot8((int)x[i], 0x12345678, (int)x[i], false);
#elif UBENCH == 4
                x[i] = x[i] * 5u + __float_as_uint(__uint_as_float(x[i]) + 1.0f);
#endif
            }
        }
        unsigned r = 0; float fs = 0.f;
#pragma unroll
        for (int i = 0; i < 8; ++i) { r ^= x[i]; fs += a[i].x + a[i].y; }
        if ((r ^ __float_as_uint(fs)) == 0x12345678u) ((unsigned*)(ws + WS_MISC))[1000 + (tid & 7)] = r;
    }
#endif
#undef IN_PH
#undef SEAM
}

extern "C" void kernel_launch(void* const* d_in, const int* in_sizes, int n_in, void* d_out, int out_size, void* d_ws, size_t ws_size, hipStream_t stream) {
    static int grid = 0;
    if (grid == 0) {
        if (n_in != 24 || in_sizes[0] != NT * DM || out_size != NT * DM || ws_size < WS_END) {
            fprintf(stderr, "kernel_launch: unexpected shapes (n_in %d, in0 %d, out %d, ws %zu); nothing launched\n", n_in, n_in > 0 ? in_sizes[0] : -1, out_size, ws_size); grid = -1; return; }
        int dev = 0, cus = 0, per_cu = 0;
        hipGetDevice(&dev); hipDeviceGetAttribute(&cus, hipDeviceAttributeMultiprocessorCount, dev);
        if (hipFuncSetAttribute((const void*)mega_fwd, hipFuncAttributeMaxDynamicSharedMemorySize, LDS_BYTES) != hipSuccess) { fprintf(stderr, "kernel_launch: hipFuncSetAttribute failed\n"); grid = -1; return; }
        if (hipOccupancyMaxActiveBlocksPerMultiprocessor(&per_cu, (const void*)mega_fwd, NWAVES * 64, LDS_BYTES) != hipSuccess || per_cu < 1) { fprintf(stderr, "kernel_launch: occupancy query says %d\n", per_cu); per_cu = 1; }
        (void)hipGetLastError();
        grid = cus;
        if (grid > 256) grid = 256;
    }
    if (grid < 0) return;
    if (hipMemsetAsync((char*)d_ws + WS_BAR, 0, 131072, stream) != hipSuccess) { fprintf(stderr, "kernel_launch: hipMemsetAsync failed\n"); return; }
    Params p{};
    for (int i = 0; i < 24; ++i) p.in[i] = (const float*)d_in[i];
    p.out = (float*)d_out; p.ws = (unsigned char*)d_ws;
#if N_LAUNCH_MODE == 1
    p.ph_lo = 0; p.ph_hi = 8; p.alt = 0;
    void* args[] = {&p};
    hipError_t e = hipLaunchCooperativeKernel((const void*)mega_fwd, dim3(grid), dim3(NWAVES * 64), args, LDS_BYTES, stream);
    if (e != hipSuccess) fprintf(stderr, "kernel_launch: cooperative launch failed: %s (grid %d)\n", hipGetErrorString(e), grid);
#else
    for (int ph = 0; ph < 8; ++ph) {
        p.ph_lo = ph; p.ph_hi = ph + 1;
        for (int rep = 0; rep < ((ph == REPEAT_LAUNCH) ? 2 : 1); ++rep) {
            p.alt = (ph == REPEAT_LAUNCH && rep == 0) ? 1 : 0;
            hipLaunchKernelGGL(mega_fwd, dim3(grid), dim3(NWAVES * 64), LDS_BYTES, stream, p);
        }
    }
#endif
}
```
